# Optimizing an MI355X kernel written in HIP

```python
import math
import jax, jax.numpy as jnp
from jax import lax
import numpy as np

D_MODEL = 1024
BATCH = 8
SEQ = 2048
DEPTH = 1
DEC_BATCH = 128
DEC_SEQ = 1
PAST_LEN = 16384
PAGE_SIZE = 128

CHUNK = 128
GMLP_WIDTH = D_MODEL
GMLP_GROUPS = 8
GMLP_GROUP_CH = GMLP_WIDTH // GMLP_GROUPS
SSM_GROUP_CH = 16
SSM_WIDTH = D_MODEL // 2
SSM_GROUPS = SSM_WIDTH // SSM_GROUP_CH
SSM_STATE = 64
IN_WIDTH = 2 * GMLP_WIDTH + SSM_WIDTH + 2 * D_MODEL
D_FF = int(math.ceil(8 * D_MODEL / 3 / 256) * 256)
EPS = 1e-6

kernel_name = "gmlp_s5_gated_hybrid_step"


def rmsnorm(x, g):
    xf = x.astype(jnp.float32)
    y = xf * lax.rsqrt(jnp.mean(xf * xf, axis=-1, keepdims=True) + EPS)
    return (y * g.astype(jnp.float32)).astype(x.dtype)


def layernorm(x, g, b):
    xf = x.astype(jnp.float32)
    mu = jnp.mean(xf, axis=-1, keepdims=True)
    var = jnp.mean(jnp.square(xf - mu), axis=-1, keepdims=True)
    y = (xf - mu) * lax.rsqrt(var + EPS)
    return (y * g.astype(jnp.float32) + b.astype(jnp.float32)).astype(x.dtype)


def chunk_spatial_gate(u, v, w_spatial, b_spatial):
    bsz, length, _ = v.shape
    n_chunks = -(-length // CHUNK)
    pad = n_chunks * CHUNK - length
    vp = jnp.pad(v, ((0, 0), (0, pad), (0, 0))).reshape(bsz, n_chunks, CHUNK, GMLP_GROUPS, GMLP_GROUP_CH)
    mask = jnp.tril(jnp.ones((CHUNK, CHUNK), dtype=bool))
    w = jnp.where(mask[None], w_spatial, jnp.zeros_like(w_spatial))
    mixed = jnp.einsum('gts,bnsgc->bntgc', w, vp) + b_spatial.T[None, None, :, :, None]
    mixed = mixed.reshape(bsz, n_chunks * CHUNK, GMLP_WIDTH)[:, :length]
    return u * mixed


def s5_scan(s, h0_re, h0_im, lam_re, lam_im, log_dt, b_re, b_im, c_re, c_im, d_skip):
    f32 = jnp.float32
    bsz, length, _ = s.shape
    u = s.astype(f32).reshape(bsz, length, SSM_GROUPS, SSM_GROUP_CH)
    lam = lax.complex(lam_re.astype(f32), lam_im.astype(f32))
    dt = jnp.exp(log_dt.astype(f32))[:, None]
    lam_bar = jnp.exp(lam * dt)
    b_mat = lax.complex(b_re.astype(f32), b_im.astype(f32))
    b_bar = ((lam_bar - 1.0) / lam)[..., None] * b_mat
    bu = jnp.einsum('gph,blgh->blgp', b_bar, u.astype(jnp.complex64))
    h0 = lax.complex(h0_re.astype(f32), h0_im.astype(f32))
    bu = bu.at[:, 0].add(lam_bar[None] * h0)
    a = jnp.broadcast_to(lam_bar, bu.shape)

    def combine(e1, e2):
        a1, b1 = e1
        a2, b2 = e2
        return a1 * a2, a2 * b1 + b2

    _, h = lax.associative_scan(combine, (a, bu), axis=1)
    c_mat = lax.complex(c_re.astype(f32), c_im.astype(f32))
    y = jnp.einsum('ghp,blgp->blgh', c_mat, h).real \
        + d_skip.astype(f32).reshape(SSM_GROUPS, SSM_GROUP_CH) * u
    h_last = h[:, -1]
    return y.reshape(bsz, length, SSM_WIDTH), jnp.real(h_last), jnp.imag(h_last)


def layer(x, h0_re, h0_im, norm_mix_g, w_in, ln_v_g, ln_v_b, w_spatial, b_spatial,
          lam_re, lam_im, log_dt, b_re, b_im, c_re, c_im, d_skip,
          w_branch_a, w_branch_b, w_out, norm_ffn_g, w_gate_ffn, w_up_ffn, w_down_ffn):
    h = rmsnorm(x, norm_mix_g)
    z = h @ w_in
    u, v, s, ga, gb = jnp.split(
        z, [GMLP_WIDTH, 2 * GMLP_WIDTH, 2 * GMLP_WIDTH + SSM_WIDTH, 2 * GMLP_WIDTH + SSM_WIDTH + D_MODEL], axis=-1)
    u = jax.nn.gelu(u)
    v = layernorm(jax.nn.gelu(v), ln_v_g, ln_v_b)
    ya = chunk_spatial_gate(u, v, w_spatial, b_spatial) @ w_branch_a
    ys, h_re, h_im = s5_scan(s, h0_re, h0_im, lam_re, lam_im, log_dt, b_re, b_im, c_re, c_im, d_skip)
    pb = ys.astype(x.dtype) @ w_branch_b
    yb = pb[..., :D_MODEL] * jax.nn.sigmoid(pb[..., D_MODEL:])
    merged = jax.nn.sigmoid(ga) * ya + jax.nn.sigmoid(gb) * yb
    x = x + merged @ w_out
    h2 = rmsnorm(x, norm_ffn_g)
    x = x + (jax.nn.silu(h2 @ w_gate_ffn) * (h2 @ w_up_ffn)) @ w_down_ffn
    return x, h_re, h_im, v


def setup_inputs(seed: int = 0) -> dict:
    key = jax.random.key(seed)
    ks = jax.random.split(key, 32)
    f32 = jnp.float32
    nrm = lambda k, shape, scale: jax.random.normal(k, shape, f32) * scale
    n_idx = jnp.arange(SSM_STATE, dtype=f32)
    lam_re = -0.5 + nrm(ks[0], (DEPTH, SSM_GROUPS, SSM_STATE), 0.01)
    lam_im = math.pi * n_idx[None, None, :] + nrm(ks[1], (DEPTH, SSM_GROUPS, SSM_STATE), 0.01)
    log_dt = jax.random.uniform(ks[2], (DEPTH, SSM_GROUPS), f32, math.log(1e-3), math.log(1e-1))
    return {
        "x_prompt": nrm(ks[3], (BATCH, SEQ, D_MODEL), 1.0),
        "x_sample": nrm(ks[4], (DEC_BATCH, DEC_SEQ, D_MODEL), 1.0),
        "state_ssm_re": nrm(ks[5], (DEPTH, DEC_BATCH, SSM_GROUPS, SSM_STATE), 1.0),
        "state_ssm_im": nrm(ks[6], (DEPTH, DEC_BATCH, SSM_GROUPS, SSM_STATE), 1.0),
        "norm_mix_g": 1.0 + nrm(ks[7], (DEPTH, D_MODEL), 0.02),
        "w_in": nrm(ks[8], (DEPTH, D_MODEL, IN_WIDTH), D_MODEL ** -0.5),
        "ln_v_g": 1.0 + nrm(ks[9], (DEPTH, GMLP_WIDTH), 0.02),
        "ln_v_b": nrm(ks[10], (DEPTH, GMLP_WIDTH), 0.02),
        "w_spatial": nrm(ks[11], (DEPTH, GMLP_GROUPS, CHUNK, CHUNK), CHUNK ** -0.5),
        "b_spatial": 1.0 + nrm(ks[12], (DEPTH, GMLP_GROUPS, CHUNK), 0.02),
        "ssm_lam_re": lam_re,
        "ssm_lam_im": lam_im,
        "ssm_log_dt": log_dt,
        "ssm_b_re": nrm(ks[13], (DEPTH, SSM_GROUPS, SSM_STATE, SSM_GROUP_CH), (2 * SSM_GROUP_CH) ** -0.5),
        "ssm_b_im": nrm(ks[14], (DEPTH, SSM_GROUPS, SSM_STATE, SSM_GROUP_CH), (2 * SSM_GROUP_CH) ** -0.5),
        "ssm_c_re": nrm(ks[15], (DEPTH, SSM_GROUPS, SSM_GROUP_CH, SSM_STATE), (2 * SSM_STATE) ** -0.5),
        "ssm_c_im": nrm(ks[16], (DEPTH, SSM_GROUPS, SSM_GROUP_CH, SSM_STATE), (2 * SSM_STATE) ** -0.5),
        "ssm_d": nrm(ks[17], (DEPTH, SSM_WIDTH), 1.0),
        "w_branch_a": nrm(ks[18], (DEPTH, GMLP_WIDTH, D_MODEL), GMLP_WIDTH ** -0.5),
        "w_branch_b": nrm(ks[19], (DEPTH, SSM_WIDTH, 2 * D_MODEL), SSM_WIDTH ** -0.5),
        "w_out": nrm(ks[20], (DEPTH, D_MODEL, D_MODEL), D_MODEL ** -0.5),
        "norm_ffn_g": 1.0 + nrm(ks[21], (DEPTH, D_MODEL), 0.02),
        "w_gate_ffn": nrm(ks[22], (DEPTH, D_MODEL, D_FF), D_MODEL ** -0.5),
        "w_up_ffn": nrm(ks[23], (DEPTH, D_MODEL, D_FF), D_MODEL ** -0.5),
        "w_down_ffn": nrm(ks[24], (DEPTH, D_FF, D_MODEL), D_FF ** -0.5),
        "norm_final_g": 1.0 + nrm(ks[25], (D_MODEL,), 0.02),
    }


def reference(x_prompt, x_sample, state_ssm_re, state_ssm_im, norm_mix_g, w_in, ln_v_g, ln_v_b,
              w_spatial, b_spatial, ssm_lam_re, ssm_lam_im, ssm_log_dt, ssm_b_re, ssm_b_im,
              ssm_c_re, ssm_c_im, ssm_d, w_branch_a, w_branch_b, w_out, norm_ffn_g,
              w_gate_ffn, w_up_ffn, w_down_ffn, norm_final_g):
    xp, xs = x_prompt, x_sample
    zeros_state = jnp.zeros((x_prompt.shape[0], SSM_GROUPS, SSM_STATE), jnp.float32)
    p_re, p_im, s_re, s_im, s_v = [], [], [], [], []
    for l in range(DEPTH):
        params = (norm_mix_g[l], w_in[l], ln_v_g[l], ln_v_b[l], w_spatial[l], b_spatial[l],
                  ssm_lam_re[l], ssm_lam_im[l], ssm_log_dt[l], ssm_b_re[l], ssm_b_im[l],
                  ssm_c_re[l], ssm_c_im[l], ssm_d[l], w_branch_a[l], w_branch_b[l], w_out[l],
                  norm_ffn_g[l], w_gate_ffn[l], w_up_ffn[l], w_down_ffn[l])
        xp, hr, hi, _ = layer(xp, zeros_state, zeros_state, *params)
        p_re.append(hr)
        p_im.append(hi)
        xs, hr, hi, v_rows = layer(xs, state_ssm_re[l], state_ssm_im[l], *params)
        s_re.append(hr)
        s_im.append(hi)
        s_v.append(v_rows)
    y_prompt = rmsnorm(xp, norm_final_g)
    y_sample = rmsnorm(xs, norm_final_g)
    new_ssm_re_prompt = jnp.stack(p_re)
    new_ssm_im_prompt = jnp.stack(p_im)
    new_ssm_re_sample = jnp.stack(s_re)
    new_ssm_im_sample = jnp.stack(s_im)
    new_chunk_v_sample = jnp.stack(s_v)
    return (y_prompt, y_sample, new_ssm_re_prompt, new_ssm_im_prompt, new_ssm_re_sample, new_ssm_im_sample, new_chunk_v_sample)
```

```cpp
#include <hip/hip_runtime.h>
#include <cstdio>
#include <cstdint>
#define DBG_NPH 9
#define DBG_LASTPH -1

#define GAS __attribute__((address_space(1)))
#define LAS __attribute__((address_space(3)))
typedef unsigned short bf16_t;
typedef short bf16x8 __attribute__((ext_vector_type(8)));
typedef short s16x4 __attribute__((ext_vector_type(4)));
typedef float f32x4 __attribute__((ext_vector_type(4)));
typedef float f32x2 __attribute__((ext_vector_type(2)));
typedef unsigned u32x4 __attribute__((ext_vector_type(4)));
typedef unsigned u32x2 __attribute__((ext_vector_type(2)));

constexpr int D = 1024, MPR = 16384, MSA = 128, MREAL = MPR + MSA, MP = 16640;
constexpr int NIN = 4608, DFF = 2816, SW = 512, NGU = 2 * DFF, SEQ = 2048, NB = 8;
constexpr int SG = 32, SP = 64, SH = 16, TC = 32, NCH = SEQ / TC;
constexpr float EPS = 1e-6f;
constexpr int NWAVES = 8, NTHR = 512;
constexpr int LDS_BYTES = 163840, LDSCTL_OFF = 162816;

constexpr size_t O_Y = 0, O_PRE = 16908288, O_PIM = 16924672, O_SRE = 16941056, O_SIM = 17203200, O_CV = 17465344;

constexpr size_t A34 = (size_t)MP * D * 2, A17 = (size_t)MP * SW * 2;
constexpr size_t WS_CTL = 0, CTL_ZERO_BYTES = 1u << 20;
constexpr size_t WS_WIN = 1u << 20;
constexpr size_t WS_WA = WS_WIN + (size_t)NIN * D * 2;
constexpr size_t WS_WB = WS_WA + (size_t)D * D * 2;
constexpr size_t WS_WO = WS_WB + (size_t)2 * D * SW * 2;
constexpr size_t WS_WGU = WS_WO + (size_t)D * D * 2;
constexpr size_t WS_WD = WS_WGU + (size_t)NGU * D * 2;
constexpr size_t WS_WSP = WS_WD + (size_t)D * DFF * 2;
constexpr size_t WS_KK = WS_WSP + 8 * 128 * 128 * 2;
constexpr size_t WS_CCAR = WS_KK + (size_t)SG * TC * SH * 32 * 2;
constexpr size_t WS_BST = WS_CCAR + (size_t)SG * 512 * 128 * 2;
constexpr size_t WS_LAMT = WS_BST + (size_t)SG * 128 * 512 * 2;
constexpr size_t WS_RSTD1 = WS_LAMT + SG * SP * 2 * 4;
constexpr size_t WS_VSTAT = WS_RSTD1 + (size_t)MP * 4;
constexpr size_t WS_RS2P = WS_VSTAT + (size_t)MP * 32 * 4;
constexpr size_t WS_RS3P = WS_RS2P + (size_t)MP * 16 * 4;
constexpr size_t WS_TAB_END = WS_RS3P + (size_t)MP * 16 * 4;
constexpr size_t WS_U = 48u << 20;
constexpr size_t WS_GV = WS_U + A34;
constexpr size_t WS_SB = WS_GV + A34;
constexpr size_t WS_YS = WS_SB + A17;
constexpr size_t WS_SGA = WS_YS + A17;
constexpr size_t WS_SGB = WS_SGA + A34;
constexpr size_t WS_XB = WS_SGB + A34;
constexpr size_t WS_T2 = WS_GV;
constexpr size_t WS_END = WS_XB + A34;
static_assert(WS_TAB_END <= WS_U, "tables fit under 48 MiB");
static_assert(WS_END <= 268435456ull, "d_ws map fits 256 MiB");
static_assert((size_t)MP * DFF * 2 <= 3 * A34, "H overlay fits");
constexpr int CW_BAR = 4096;

typedef __bf16 bf16x2_t __attribute__((ext_vector_type(2)));
__device__ __forceinline__ unsigned cvt_pk_bf16(float lo, float hi) { const bf16x2_t r = __builtin_convertvector((f32x2){lo, hi}, bf16x2_t); return __builtin_bit_cast(unsigned, r); }
__device__ __forceinline__ float bf_lo(unsigned w) { return __uint_as_float(w << 16); }
__device__ __forceinline__ float bf_hi(unsigned w) { return __uint_as_float(w & 0xffff0000u); }
__device__ __forceinline__ float bf1(bf16_t h) { return __uint_as_float(((unsigned)h) << 16); }
__device__ __forceinline__ float fast_sigmoid(float x) { return __builtin_amdgcn_rcpf(1.0f + __builtin_amdgcn_exp2f(-1.4426950408889634f * x)); }
__device__ __forceinline__ float gelu_tanh(float x) { const float t = 1.5957691216057308f * (x + 0.044715f * x * x * x); return x * fast_sigmoid(t); }
__device__ __forceinline__ float wave_sum(float v) {
#pragma unroll
    for (int o = 1; o < 64; o <<= 1) v += __shfl_xor(v, o);
    return v;
}

#define XB_TMO      128
#define XB_XCNT(j)  (256  + 64 * (j))
#define XB_XSUB(j)  (1280 + 64 * (j))
#define XB_XGEN(j)  (2304 + 64 * (j))
#define XB_TOP      3328
#define XB_TOPGEN   3392
#define XCD_BAR_WORDS 3456
#define XB_SPIN_CAP (1u << 18)
__device__ __forceinline__ unsigned xb_ld(unsigned* p)              { return __hip_atomic_load(p, __ATOMIC_RELAXED, __HIP_MEMORY_SCOPE_AGENT); }
__device__ __forceinline__ unsigned xb_add(unsigned* p, unsigned v) { return __hip_atomic_fetch_add(p, v, __ATOMIC_RELAXED, __HIP_MEMORY_SCOPE_AGENT); }
__device__ __forceinline__ unsigned xb_xcc_id() { return (unsigned)__builtin_amdgcn_s_getreg((3 << 11) | 20) & 0xFu; }
#define XB_SPIN(cond, bar) do { unsigned _sp = 0; while (cond) { __builtin_amdgcn_s_sleep(1); \
    if ((++_sp & 255u) == 0u) { if (xb_ld(&(bar)[XB_TMO])) break; if (_sp > XB_SPIN_CAP) { atomicAdd(&(bar)[XB_TMO], 1u); break; } } } } while (0)
struct XcdBarrier { unsigned* bar; unsigned x; volatile LAS unsigned* st; };
__device__ __forceinline__ XcdBarrier xcd_barrier_post(unsigned* bar, volatile LAS unsigned* st) {
    XcdBarrier b; b.bar = bar; b.x = xb_xcc_id(); b.st = st;
    if (threadIdx.x == 0) (void)xb_add(&bar[XB_XCNT(b.x)], 1u);
    return b;
}
__device__ __forceinline__ void xcd_barrier_complete(unsigned* bar, unsigned x, unsigned& nloc, unsigned& nx) {
    const unsigned G = gridDim.x * gridDim.y * gridDim.z;
    unsigned sum, cnt, mine, sp = 0u;
    for (;;) {
        sum = 0u; cnt = 0u; mine = 0u;
#pragma unroll
        for (unsigned j = 0; j < 16; ++j) { const unsigned c = xb_ld(&bar[XB_XCNT(j)]); sum += c; cnt += (c > 0u) ? 1u : 0u; mine = (j == x) ? c : mine; }
        if (sum == G) break;
        __builtin_amdgcn_s_sleep(1);
        if ((++sp & 255u) == 0u) { if (xb_ld(&bar[XB_TMO])) break; if (sp > XB_SPIN_CAP) { atomicAdd(&bar[XB_TMO], 1u); break; } }
    }
    nloc = mine > 0u ? mine : 1u; nx = cnt > 0u ? cnt : 1u;
}
__device__ __forceinline__ void xcd_barrier(const XcdBarrier& b) {
    asm volatile("s_waitcnt vmcnt(0)" ::: "memory");
    __syncthreads();
    if (threadIdx.x == 0) {
        unsigned* bar = b.bar;
        __builtin_amdgcn_s_waitcnt(0);
        unsigned nloc = b.st[0], nx = b.st[1];
        if (nloc == 0u) { xcd_barrier_complete(bar, b.x, nloc, nx); b.st[0] = nloc; b.st[1] = nx; }
        const unsigned old = xb_add(&bar[XB_XSUB(b.x)], 1u);
        const unsigned gen = old / nloc;
        if (old + 1u == (gen + 1u) * nloc) {
            __builtin_amdgcn_fence(__ATOMIC_RELEASE, "agent");
            asm volatile("s_waitcnt vmcnt(0)" ::: "memory");
            const unsigned og = xb_add(&bar[XB_TOP], 1u);
            const unsigned tg = og / nx;
            if (og + 1u == (tg + 1u) * nx) xb_add(&bar[XB_TOPGEN], 1u);
            else XB_SPIN(xb_ld(&bar[XB_TOPGEN]) == tg, bar);
            __builtin_amdgcn_fence(__ATOMIC_ACQUIRE, "agent");
            xb_add(&bar[XB_XGEN(b.x)], 1u);
            asm volatile("s_waitcnt vmcnt(0)" ::: "memory");
        } else {
            XB_SPIN(xb_ld(&bar[XB_XGEN(b.x)]) == gen, bar);
            __builtin_amdgcn_fence(__ATOMIC_ACQUIRE, "agent");
            asm volatile("s_waitcnt vmcnt(0)" ::: "memory");
        }
    }
    __syncthreads();
}

namespace pg8 {
constexpr int BM = 256, BK = 64, HALF = 128, HTB = HALF * BK * 2, STAGE_BYTES = 8 * HTB, NXCD = 8, WGM = 8;
__host__ __device__ __forceinline__ int lds_byte(int r, int c) { const int st = (r >> 4) * 2 + (c >> 5), rr = r & 15, cc = c & 31, ob = rr * 64 + cc * 2; return st * 1024 + (ob ^ (((ob >> 9) & 1) << 5)); }
__host__ __device__ __forceinline__ void stage_rc(int b, int& R, int& C) { const int st = b / 1024, sb = b % 1024, swz = sb ^ (((sb >> 9) & 1) << 5); R = (st >> 1) * 16 + swz / 64; C = (st & 1) * 32 + (swz % 64) / 2; }
__host__ __device__ __forceinline__ int perm32(int rho) { const int n = rho >> 4, i = rho & 15; return 8 * (i >> 2) + 4 * n + (i & 3); }
struct Unit { int pm, pn; };
struct Gemm { const bf16_t* A; const bf16_t* Bt; int M, N, K; };
struct StaticOrder {
    int nM, nN, nwg, G, c;
    __host__ __device__ void init(int M, int N, int G_, int c_) { nM = M / BM; nN = N / BM; nwg = nM * nN; G = G_; c = c_; }
    __host__ __device__ bool next(int i, Unit& u) const {
        const long L = (long)i * G + c; if (L >= nwg) return false;
        int wgid = (int)L; { const int q = nwg / NXCD, r = nwg % NXCD, xcd = wgid % NXCD, off = wgid / NXCD; wgid = (xcd < r ? xcd * (q + 1) : r * (q + 1) + (xcd - r) * q) + off; }
        const int nig = WGM * nN, gid = wgid / nig, fm = gid * WGM, gsz = (nM - fm) < WGM ? (nM - fm) : WGM;
        u.pm = fm + ((wgid % nig) % gsz); u.pn = (wgid % nig) / gsz; return true;
    }
    __device__ __forceinline__ void a_ready(const Unit&) const {}
    __device__ __forceinline__ void done(const Unit&) const {}
};

template <class Epi, class Sched, bool ALIGN_EPI = true>
__device__ __forceinline__ void gemm_phase(LAS unsigned char* lds, const Gemm g, const Sched& S, const Epi& E) {
    const int tid = threadIdx.x, wid = __builtin_amdgcn_readfirstlane(tid >> 6), lane = tid & 63, wr = wid >> 2, wc = wid & 3, fr = lane & 15, fq = lane >> 4;
    const int K = g.K, nt = K / BK;
    unsigned voffA[2], voffB[2];
#pragma unroll
    for (int i = 0; i < 2; ++i) { int R, C; stage_rc(tid * 16 + i * 8192, R, C); const int Rb = Epi::PERM ? ((R & ~31) + perm32(R & 31)) : R;
        voffA[i] = (unsigned)(R * K + C) * 2u; voffB[i] = (unsigned)(Rb * K + C) * 2u; }
    const size_t kstep = (size_t)(BK * 2);
    const size_t hstep = (size_t)HALF * K * 2;
    const size_t tstep = 2 * hstep;
    const unsigned ldsw = (unsigned)wid * 1024u;
    const int aoff = lds_byte(wr * 64 + fr, fq * 8), boff = lds_byte(wc * 32 + fr, fq * 8);
#define PG8_SA(b, h) (((b) * 2 + (h)) * HTB)
#define PG8_SB(b, h) ((4 + (b) * 2 + (h)) * HTB)
#define PG8_STAGE(bufoff, gbase, voff) do { _Pragma("unroll") for (int _i = 0; _i < 2; ++_i) \
        __builtin_amdgcn_global_load_lds((const unsigned*)((const char*)(gbase) + (voff)[_i]), (LAS unsigned*)(lds + (bufoff) + ldsw + _i * 8192), 16, 0, 0); } while (0)
#define PG8_LDA(dst, b, h) do { _Pragma("unroll") for (int m = 0; m < 4; ++m) _Pragma("unroll") for (int k = 0; k < 2; ++k) dst[m][k] = *(const LAS bf16x8*)(lds + PG8_SA(b, h) + aoff + m * 2048 + k * 1024); } while (0)
#define PG8_LDB(dst, b, h) do { _Pragma("unroll") for (int n = 0; n < 2; ++n) _Pragma("unroll") for (int k = 0; k < 2; ++k) dst[n][k] = *(const LAS bf16x8*)(lds + PG8_SB(b, h) + boff + n * 2048 + k * 1024); } while (0)
#define PG8_MMA(ai, bj, At, Bt) do { __builtin_amdgcn_s_setprio(1); _Pragma("unroll") for (int m = 0; m < 4; ++m) _Pragma("unroll") for (int n = 0; n < 2; ++n) _Pragma("unroll") for (int k = 0; k < 2; ++k) \
        acc[ai][bj][m][n] = __builtin_amdgcn_mfma_f32_16x16x32_bf16(Bt[n][k], At[m][k], acc[ai][bj][m][n], 0, 0, 0); __builtin_amdgcn_s_setprio(0); } while (0)
#define PG8_WAIT_V(n) asm volatile("s_waitcnt vmcnt(" #n ")" ::: "memory")
#define PG8_WAIT_L(n) asm volatile("s_waitcnt lgkmcnt(" #n ")" ::: "memory")
#define PG8_BAR __builtin_amdgcn_s_barrier()
#define PG8_SCHED __builtin_amdgcn_sched_barrier(0)
    Unit cur, nxt; int ui = 0;
    if (!S.next(0, cur)) return;
    f32x4 acc[2][2][4][2];
#pragma unroll
    for (int a = 0; a < 2; ++a)
#pragma unroll
        for (int b = 0; b < 2; ++b)
#pragma unroll
            for (int m = 0; m < 4; ++m)
#pragma unroll
                for (int n = 0; n < 2; ++n) acc[a][b][m][n] = (f32x4){0.f, 0.f, 0.f, 0.f};
    bf16x8 At[4][2], B0[2][2], B1[2][2];
    const char* cA = (const char*)g.A + (size_t)cur.pm * tstep; const char* cB = (const char*)g.Bt + (size_t)cur.pn * tstep;
    S.a_ready(cur);
    PG8_STAGE(PG8_SB(0, 0), cB, voffB); PG8_STAGE(PG8_SB(0, 1), cB + hstep, voffB); PG8_STAGE(PG8_SA(0, 0), cA, voffA); PG8_STAGE(PG8_SA(0, 1), cA + hstep, voffA);
    if (wr == 1) PG8_BAR;
    PG8_WAIT_V(2); PG8_BAR;
    PG8_STAGE(PG8_SB(1, 0), cB + kstep, voffB); PG8_STAGE(PG8_SA(1, 0), cA + kstep, voffA); PG8_STAGE(PG8_SB(1, 1), cB + hstep + kstep, voffB);
    PG8_WAIT_V(6); PG8_BAR;
    for (;;) {
        const bool has_next = S.next(ui + 1, nxt);
        const char* nA = has_next ? (const char*)g.A + (size_t)nxt.pm * tstep : cA; const char* nB = has_next ? (const char*)g.Bt + (size_t)nxt.pn * tstep : cB;
        for (int t = 0; t < nt; t += 2) {
            const bool last = (t == nt - 2);
            const char* a1 = cA + (size_t)(t + 1) * kstep;
            const char* a2 = last ? nA : cA + (size_t)(t + 2) * kstep; const char* b2 = last ? nB : cB + (size_t)(t + 2) * kstep;
            const char* a3 = a2 + kstep; const char* b3 = b2 + kstep;
            if (last && has_next) S.a_ready(nxt);
            PG8_LDB(B0, 0, 0); PG8_LDB(B1, 0, 1); PG8_SCHED; PG8_LDA(At, 0, 0); PG8_STAGE(PG8_SA(1, 1), a1 + hstep, voffA);
            PG8_WAIT_V(8); PG8_WAIT_L(0); PG8_BAR; PG8_MMA(0, 0, At, B0); PG8_MMA(0, 1, At, B1); PG8_BAR; PG8_SCHED;
            PG8_LDA(At, 0, 1); PG8_STAGE(PG8_SB(0, 0), b2, voffB); PG8_STAGE(PG8_SB(0, 1), b2 + hstep, voffB); PG8_STAGE(PG8_SA(0, 0), a2, voffA);
            PG8_WAIT_V(8); PG8_WAIT_L(0); PG8_BAR; PG8_MMA(1, 0, At, B0); PG8_MMA(1, 1, At, B1); PG8_BAR; PG8_SCHED;
            PG8_LDB(B0, 1, 0); PG8_LDB(B1, 1, 1); PG8_SCHED; PG8_LDA(At, 1, 0); PG8_STAGE(PG8_SA(0, 1), a2 + hstep, voffA);
            PG8_WAIT_V(8); PG8_WAIT_L(0); PG8_BAR; PG8_MMA(0, 0, At, B0); PG8_MMA(0, 1, At, B1); PG8_BAR; PG8_SCHED;
            PG8_LDA(At, 1, 1); PG8_STAGE(PG8_SB(1, 0), b3, voffB); PG8_STAGE(PG8_SB(1, 1), b3 + hstep, voffB); PG8_STAGE(PG8_SA(1, 0), a3, voffA);
            PG8_WAIT_V(8); PG8_WAIT_L(0); PG8_BAR; PG8_MMA(1, 0, At, B0); PG8_MMA(1, 1, At, B1); PG8_BAR; PG8_SCHED;
        }
        if constexpr (ALIGN_EPI) { if (wr == 0) PG8_BAR; }
        E(acc, cur, wr, wc, fr, fq, lane); S.done(cur);
        if (!has_next) break;
#pragma unroll
        for (int a = 0; a < 2; ++a)
#pragma unroll
            for (int b = 0; b < 2; ++b)
#pragma unroll
                for (int m = 0; m < 4; ++m)
#pragma unroll
                    for (int n = 0; n < 2; ++n) acc[a][b][m][n] = (f32x4){0.f, 0.f, 0.f, 0.f};
        cur = nxt; cA = nA; cB = nB; ++ui;
        if constexpr (ALIGN_EPI) { if (wr == 1) PG8_BAR; }
    }
    PG8_WAIT_V(0);
    if constexpr (!ALIGN_EPI) { if (wr == 0) PG8_BAR; }
    PG8_BAR;
#undef PG8_SA
#undef PG8_SB
#undef PG8_STAGE
#undef PG8_LDA
#undef PG8_LDB
#undef PG8_MMA
#undef PG8_WAIT_V
#undef PG8_WAIT_L
#undef PG8_BAR
#undef PG8_SCHED
}
}
using pg8::Unit;

typedef f32x4 AccT[2][2][4][2];

__device__ __forceinline__ void fetch_rowscale(const float* P16, int pm, int wr, int lane, int fr, float (&rs)[2][4]) {
    float v[2];
#pragma unroll
    for (int ai = 0; ai < 2; ++ai) {
        const f32x4* p = (const f32x4*)(P16 + (size_t)(pm * 256 + ai * 128 + wr * 64 + lane) * 16);
        const f32x4 a = p[0], b = p[1], c = p[2], d = p[3];
        const float s = ((a[0] + a[1]) + (a[2] + a[3])) + ((b[0] + b[1]) + (b[2] + b[3])) + ((c[0] + c[1]) + (c[2] + c[3])) + ((d[0] + d[1]) + (d[2] + d[3]));
        v[ai] = __builtin_amdgcn_rsqf(s * (1.0f / D) + EPS);
    }
#pragma unroll
    for (int ai = 0; ai < 2; ++ai)
#pragma unroll
        for (int m = 0; m < 4; ++m) rs[ai][m] = __shfl(v[ai], m * 16 + fr);
}

struct Epi1 {
    static constexpr bool PERM = true;
    bf16_t *U, *GV, *SB, *SGA, *SGB; const float* rstd; float* vstat;
    __device__ __forceinline__ void operator()(const AccT& acc, const Unit& u, int wr, int wc, int fr, int fq, int lane) const {
        const int row0 = u.pm * 256 + wr * 64 + fr, pn = u.pn;
        const int type = pn < 4 ? 0 : pn < 8 ? 1 : pn < 10 ? 2 : pn < 14 ? 3 : 4;
        const int pnl = pn - (type == 0 ? 0 : type == 1 ? 4 : type == 2 ? 8 : type == 3 ? 10 : 14);
        bf16_t* base = type == 0 ? U : type == 1 ? GV : type == 3 ? SGA : SGB;
#pragma unroll
        for (int ai = 0; ai < 2; ++ai)
#pragma unroll
            for (int m = 0; m < 4; ++m) {
                const int row = row0 + ai * 128 + m * 16; const float rs = rstd[row];
                float s1 = 0.f, s2 = 0.f;
#pragma unroll
                for (int bj = 0; bj < 2; ++bj) {
                    f32x4 v0 = acc[ai][bj][m][0] * rs, v1 = acc[ai][bj][m][1] * rs;
                    const int col = pnl * 256 + bj * 128 + wc * 32 + 8 * fq;
                    if (type <= 1) {
#pragma unroll
                        for (int j = 0; j < 4; ++j) { v0[j] = gelu_tanh(v0[j]); v1[j] = gelu_tanh(v1[j]); }
                        if (type == 1) {
#pragma unroll
                            for (int j = 0; j < 4; ++j) { s1 += v0[j] + v1[j]; s2 += v0[j] * v0[j] + v1[j] * v1[j]; }
                        }
                    } else if (type >= 3) {
#pragma unroll
                        for (int j = 0; j < 4; ++j) { v0[j] = fast_sigmoid(v0[j]); v1[j] = fast_sigmoid(v1[j]); }
                    }
                    u32x4 w; w.x = cvt_pk_bf16(v0[0], v0[1]); w.y = cvt_pk_bf16(v0[2], v0[3]); w.z = cvt_pk_bf16(v1[0], v1[1]); w.w = cvt_pk_bf16(v1[2], v1[3]);
                    if (type == 2) *(u32x4*)(SB + ((size_t)(col >> 4) * MP + row) * 16 + (col & 15)) = w;
                    else *(u32x4*)(base + (size_t)row * D + col) = w;
                }
                if (type == 1) {
                    s1 += __shfl_xor(s1, 16); s1 += __shfl_xor(s1, 32); s2 += __shfl_xor(s2, 16); s2 += __shfl_xor(s2, 32);
                    if (fq == 0) *(f32x2*)(vstat + ((size_t)row * 16 + pnl * 4 + wc) * 2) = (f32x2){s1, s2};
                }
            }
    }
};
struct Epi3a {
    static constexpr bool PERM = true;
    bf16_t* T2; const bf16_t* SGB;
    __device__ __forceinline__ void operator()(const AccT& acc, const Unit& u, int wr, int wc, int fr, int fq, int lane) const {
        const int row0 = u.pm * 256 + wr * 64 + fr, col = u.pn * 128 + wc * 32 + 8 * fq;
#pragma unroll
        for (int ai = 0; ai < 2; ++ai)
#pragma unroll
            for (int m = 0; m < 4; ++m) {
                const size_t off = (size_t)(row0 + ai * 128 + m * 16) * D + col;
                const u32x4 sg = *(const u32x4*)(SGB + off);
                const f32x4 a0 = acc[ai][0][m][0], a1 = acc[ai][0][m][1], g0 = acc[ai][1][m][0], g1 = acc[ai][1][m][1];
                u32x4 w;
                w.x = cvt_pk_bf16(bf_lo(sg.x) * a0[0] * fast_sigmoid(g0[0]), bf_hi(sg.x) * a0[1] * fast_sigmoid(g0[1]));
                w.y = cvt_pk_bf16(bf_lo(sg.y) * a0[2] * fast_sigmoid(g0[2]), bf_hi(sg.y) * a0[3] * fast_sigmoid(g0[3]));
                w.z = cvt_pk_bf16(bf_lo(sg.z) * a1[0] * fast_sigmoid(g1[0]), bf_hi(sg.z) * a1[1] * fast_sigmoid(g1[1]));
                w.w = cvt_pk_bf16(bf_lo(sg.w) * a1[2] * fast_sigmoid(g1[2]), bf_hi(sg.w) * a1[3] * fast_sigmoid(g1[3]));
                *(u32x4*)(T2 + off) = w;
            }
    }
};
struct Epi3b {
    static constexpr bool PERM = true;
    bf16_t* MG; const bf16_t* SGA; const bf16_t* T2;
    __device__ __forceinline__ void operator()(const AccT& acc, const Unit& u, int wr, int wc, int fr, int fq, int lane) const {
        const int row0 = u.pm * 256 + wr * 64 + fr, col0 = u.pn * 256 + wc * 32 + 8 * fq;
#pragma unroll
        for (int ai = 0; ai < 2; ++ai)
#pragma unroll
            for (int m = 0; m < 4; ++m)
#pragma unroll
                for (int bj = 0; bj < 2; ++bj) {
                    const size_t off = (size_t)(row0 + ai * 128 + m * 16) * D + col0 + bj * 128;
                    const u32x4 sg = *(const u32x4*)(SGA + off), t2 = *(const u32x4*)(T2 + off);
                    const f32x4 a0 = acc[ai][bj][m][0], a1 = acc[ai][bj][m][1];
                    u32x4 w;
                    w.x = cvt_pk_bf16(bf_lo(sg.x) * a0[0] + bf_lo(t2.x), bf_hi(sg.x) * a0[1] + bf_hi(t2.x));
                    w.y = cvt_pk_bf16(bf_lo(sg.y) * a0[2] + bf_lo(t2.y), bf_hi(sg.y) * a0[3] + bf_hi(t2.y));
                    w.z = cvt_pk_bf16(bf_lo(sg.z) * a1[0] + bf_lo(t2.z), bf_hi(sg.z) * a1[1] + bf_hi(t2.z));
                    w.w = cvt_pk_bf16(bf_lo(sg.w) * a1[2] + bf_lo(t2.w), bf_hi(sg.w) * a1[3] + bf_hi(t2.w));
                    *(u32x4*)(MG + off) = w;
                }
    }
};
struct Epi4 {
    static constexpr bool PERM = false;
    const float *xp, *xs; float* out; bf16_t* XN; float* rsp;
    __device__ __forceinline__ void operator()(const AccT& acc, const Unit& u, int wr, int wc, int fr, int fq, int lane) const {
        const int row0 = u.pm * 256 + wr * 64 + fr, col0 = u.pn * 256 + wc * 32 + 4 * fq;
#pragma unroll
        for (int ai = 0; ai < 2; ++ai)
#pragma unroll
            for (int m = 0; m < 4; ++m) {
                const int row = row0 + ai * 128 + m * 16; const bool real = row < MREAL;
                const float* xr = row < MPR ? xp + (size_t)row * D : xs + (size_t)(row - MPR) * D;
                float ss = 0.f;
#pragma unroll
                for (int bj = 0; bj < 2; ++bj)
#pragma unroll
                    for (int n = 0; n < 2; ++n) {
                        const int col = col0 + bj * 128 + n * 16;
                        f32x4 v = acc[ai][bj][m][n];
                        if (real) { v += *(const f32x4*)(xr + col); *(f32x4*)(out + (size_t)row * D + col) = v; }
                        ss += (v[0] * v[0] + v[1] * v[1]) + (v[2] * v[2] + v[3] * v[3]);
                        u32x2 w; w.x = cvt_pk_bf16(v[0], v[1]); w.y = cvt_pk_bf16(v[2], v[3]);
                        *(u32x2*)(XN + (size_t)row * D + col) = w;
                    }
                ss += __shfl_xor(ss, 16); ss += __shfl_xor(ss, 32);
                if (fq == 0) rsp[(size_t)row * 16 + u.pn * 4 + wc] = ss;
            }
    }
};
struct Epi5 {
    static constexpr bool PERM = true;
    bf16_t* H; const float* rsp;
    __device__ __forceinline__ void operator()(const AccT& acc, const Unit& u, int wr, int wc, int fr, int fq, int lane) const {
        float rs[2][4]; fetch_rowscale(rsp, u.pm, wr, lane, fr, rs);
        const int row0 = u.pm * 256 + wr * 64 + fr, col = u.pn * 128 + wc * 32 + 8 * fq;
#pragma unroll
        for (int ai = 0; ai < 2; ++ai)
#pragma unroll
            for (int m = 0; m < 4; ++m) {
                const float r = rs[ai][m];
                const f32x4 g0 = acc[ai][0][m][0] * r, g1 = acc[ai][0][m][1] * r, u0 = acc[ai][1][m][0] * r, u1 = acc[ai][1][m][1] * r;
                u32x4 w;
                w.x = cvt_pk_bf16(g0[0] * fast_sigmoid(g0[0]) * u0[0], g0[1] * fast_sigmoid(g0[1]) * u0[1]);
                w.y = cvt_pk_bf16(g0[2] * fast_sigmoid(g0[2]) * u0[2], g0[3] * fast_sigmoid(g0[3]) * u0[3]);
                w.z = cvt_pk_bf16(g1[0] * fast_sigmoid(g1[0]) * u1[0], g1[1] * fast_sigmoid(g1[1]) * u1[1]);
                w.w = cvt_pk_bf16(g1[2] * fast_sigmoid(g1[2]) * u1[2], g1[3] * fast_sigmoid(g1[3]) * u1[3]);
                *(u32x4*)(H + (size_t)(row0 + ai * 128 + m * 16) * DFF + col) = w;
            }
    }
};
struct Epi6 {
    static constexpr bool PERM = false;
    float* out; float* rsp;
    __device__ __forceinline__ void operator()(const AccT& acc, const Unit& u, int wr, int wc, int fr, int fq, int lane) const {
        const int row0 = u.pm * 256 + wr * 64 + fr, col0 = u.pn * 256 + wc * 32 + 4 * fq;
#pragma unroll
        for (int ai = 0; ai < 2; ++ai)
#pragma unroll
            for (int m = 0; m < 4; ++m) {
                const int row = row0 + ai * 128 + m * 16; const bool real = row < MREAL;
                float ss = 0.f;
                if (real) {
#pragma unroll
                    for (int bj = 0; bj < 2; ++bj)
#pragma unroll
                        for (int n = 0; n < 2; ++n) {
                            float* p = out + (size_t)row * D + col0 + bj * 128 + n * 16;
                            const f32x4 v = *(const f32x4*)p + acc[ai][bj][m][n];
                            *(f32x4*)p = v;
                            ss += (v[0] * v[0] + v[1] * v[1]) + (v[2] * v[2] + v[3] * v[3]);
                        }
                }
                ss += __shfl_xor(ss, 16); ss += __shfl_xor(ss, 32);
                if (fq == 0) rsp[(size_t)row * 16 + u.pn * 4 + wc] = ss;
            }
    }
};

__device__ __forceinline__ void cpow_lam(float lre, float lim, float dt, int n, float& mr, float& mi) {
    const float mag = expf((float)n * dt * lre);
    double a = (double)n * (double)dt * (double)lim;
    const double k = rint(a * 0.15915494309189535);
    a = fma(-k, 6.283185307179586, a);
    const double r2 = a * a;
    double s = 1.0 - r2 * (1.0 / 420.0);
    s = 1.0 - r2 * (1.0 / 342.0) * s; s = 1.0 - r2 * (1.0 / 272.0) * s; s = 1.0 - r2 * (1.0 / 210.0) * s; s = 1.0 - r2 * (1.0 / 156.0) * s;
    s = 1.0 - r2 * (1.0 / 110.0) * s; s = 1.0 - r2 * (1.0 / 72.0) * s; s = 1.0 - r2 * (1.0 / 42.0) * s; s = 1.0 - r2 * (1.0 / 20.0) * s; s = 1.0 - r2 * (1.0 / 6.0) * s;
    s *= a;
    double c = 1.0 - r2 * (1.0 / 462.0);
    c = 1.0 - r2 * (1.0 / 380.0) * c; c = 1.0 - r2 * (1.0 / 306.0) * c; c = 1.0 - r2 * (1.0 / 240.0) * c; c = 1.0 - r2 * (1.0 / 182.0) * c; c = 1.0 - r2 * (1.0 / 132.0) * c;
    c = 1.0 - r2 * (1.0 / 90.0) * c; c = 1.0 - r2 * (1.0 / 56.0) * c; c = 1.0 - r2 * (1.0 / 30.0) * c; c = 1.0 - r2 * (1.0 / 12.0) * c; c = 1.0 - r2 * (1.0 / 2.0) * c;
    mr = mag * (float)c; mi = mag * (float)s;
}
__device__ __forceinline__ void zoh_coef(float lre, float lim, float dt, float& cr, float& ci) {
    float br, bi; cpow_lam(lre, lim, dt, 1, br, bi);
    const float nr = br - 1.0f, ni = bi, den = 1.0f / (lre * lre + lim * lim);
    cr = (nr * lre + ni * lim) * den; ci = (ni * lre - nr * lim) * den;
}

struct Args { const float* in[26]; float* out; unsigned char* ws; int ph_lo, ph_hi; };
enum { I_XP = 0, I_XS, I_SRE, I_SIM, I_G1, I_WIN, I_LVG, I_LVB, I_WSP, I_BSP, I_LRE, I_LIM, I_LDT, I_BRE, I_BIM, I_CRE, I_CIM, I_SD, I_WA, I_WB, I_WO, I_G2, I_WG, I_WU, I_WD, I_GF };

__device__ __forceinline__ void p0_transpose_item(const float* W, int Nsrc, int Kdst, const float* gain, bf16_t* WT, int k0, int n0, int drow0, LAS float* scr, int lane) {
#pragma unroll 8
    for (int i = 0; i < 32; ++i) { const int kk = 2 * i + (lane >> 5); float v = W[(size_t)(k0 + kk) * Nsrc + n0 + (lane & 31)]; if (gain) v *= gain[k0 + kk]; scr[kk * 33 + (lane & 31)] = v; }
    asm volatile("s_waitcnt lgkmcnt(0)" ::: "memory");
    const int c = lane & 7;
#pragma unroll
    for (int j = 0; j < 4; ++j) { const int n = (lane >> 3) + 8 * j; const LAS float* s = scr + (8 * c) * 33 + n;
        u32x4 o; o.x = cvt_pk_bf16(s[0 * 33], s[1 * 33]); o.y = cvt_pk_bf16(s[2 * 33], s[3 * 33]); o.z = cvt_pk_bf16(s[4 * 33], s[5 * 33]); o.w = cvt_pk_bf16(s[6 * 33], s[7 * 33]);
        *(u32x4*)(WT + (size_t)(drow0 + n) * Kdst + k0 + 8 * c) = o; }
    asm volatile("s_waitcnt lgkmcnt(0)" ::: "memory");
}
__device__ __forceinline__ void p0_prologue(const Args& args, LAS unsigned char* L, int vcu, int G, int tid, int wave, int lane) {
    unsigned char* ws = args.ws;
    LAS float* scr = (LAS float*)(L + wave * 16384);
    const int gw = vcu * NWAVES + wave, NGW = G * NWAVES;
    constexpr int I_IN = 16 * 144, I_A = 16 * 32, I_B = 8 * 64, I_O = 16 * 32, I_G = 16 * 88, I_U = 16 * 88, I_D = 44 * 32;
    constexpr int NITEMS = I_IN + I_A + I_B + I_O + I_G + I_U + I_D;
    for (int it = gw; it < NITEMS; it += NGW) {
        int r = it;
        if (r < I_IN) { const int kb = r / 144, nb = r % 144; p0_transpose_item(args.in[I_WIN], NIN, D, args.in[I_G1], (bf16_t*)(ws + WS_WIN), 64 * kb, 32 * nb, 32 * nb, scr, lane); continue; } r -= I_IN;
        if (r < I_A) { const int kb = r / 32, nb = r % 32; p0_transpose_item(args.in[I_WA], D, D, nullptr, (bf16_t*)(ws + WS_WA), 64 * kb, 32 * nb, 32 * nb, scr, lane); continue; } r -= I_A;
        if (r < I_B) { const int kb = r / 64, nb = r % 64; const int n0 = 32 * nb, half = n0 >> 10, c = n0 & 1023;
            p0_transpose_item(args.in[I_WB], 2 * D, SW, nullptr, (bf16_t*)(ws + WS_WB), 64 * kb, n0, (c >> 7) * 256 + half * 128 + (c & 127), scr, lane); continue; } r -= I_B;
        if (r < I_O) { const int kb = r / 32, nb = r % 32; p0_transpose_item(args.in[I_WO], D, D, nullptr, (bf16_t*)(ws + WS_WO), 64 * kb, 32 * nb, 32 * nb, scr, lane); continue; } r -= I_O;
        if (r < I_G) { const int kb = r / 88, nb = r % 88; const int c = 32 * nb;
            p0_transpose_item(args.in[I_WG], DFF, D, args.in[I_G2], (bf16_t*)(ws + WS_WGU), 64 * kb, c, (c >> 7) * 256 + (c & 127), scr, lane); continue; } r -= I_G;
        if (r < I_U) { const int kb = r / 88, nb = r % 88; const int c = 32 * nb;
            p0_transpose_item(args.in[I_WU], DFF, D, args.in[I_G2], (bf16_t*)(ws + WS_WGU), 64 * kb, c, (c >> 7) * 256 + 128 + (c & 127), scr, lane); continue; } r -= I_U;
        { const int kb = r / 32, nb = r % 32; p0_transpose_item(args.in[I_WD], D, DFF, nullptr, (bf16_t*)(ws + WS_WD), 64 * kb, 32 * nb, 32 * nb, scr, lane); }
    }
    bf16_t* XB = (bf16_t*)(ws + WS_XB); float* rstd1 = (float*)(ws + WS_RSTD1);
    for (int m = gw; m < MP; m += NGW) {
        u32x2* o8 = (u32x2*)(XB + (size_t)m * D) + lane;
        if (m >= MREAL) {
#pragma unroll
            for (int j = 0; j < 4; ++j) o8[64 * j] = (u32x2){0u, 0u};
            if (lane == 0) rstd1[m] = 0.f;
            continue;
        }
        const float* xr = m < MPR ? args.in[I_XP] + (size_t)m * D : args.in[I_XS] + (size_t)(m - MPR) * D;
        const f32x4* xv = (const f32x4*)xr + lane;
        f32x4 v[4]; float s = 0.f;
#pragma unroll
        for (int j = 0; j < 4; ++j) { v[j] = xv[64 * j]; s += (v[j][0] * v[j][0] + v[j][1] * v[j][1]) + (v[j][2] * v[j][2] + v[j][3] * v[j][3]); }
        s = wave_sum(s);
#pragma unroll
        for (int j = 0; j < 4; ++j) o8[64 * j] = (u32x2){cvt_pk_bf16(v[j][0], v[j][1]), cvt_pk_bf16(v[j][2], v[j][3])};
        if (lane == 0) rstd1[m] = 1.0f / sqrtf(s * (1.0f / D) + EPS);
    }
    const int gt = vcu * NTHR + tid, NT = G * NTHR;
    { bf16_t* WSPb = (bf16_t*)(ws + WS_WSP); const float* wsp = args.in[I_WSP];
      for (int i = gt; i < 8 * 128 * 128; i += NT) { const int t = (i >> 7) & 127, s = i & 127; const float v = s <= t ? wsp[i] : 0.f; WSPb[i] = (bf16_t)(cvt_pk_bf16(v, 0.f) & 0xffffu); } }
    const float *lre_ = args.in[I_LRE], *lim_ = args.in[I_LIM], *ldt_ = args.in[I_LDT], *bre_ = args.in[I_BRE], *bim_ = args.in[I_BIM], *cre_ = args.in[I_CRE], *cim_ = args.in[I_CIM], *sd_ = args.in[I_SD];
    { bf16_t* KK = (bf16_t*)(ws + WS_KK);
      for (int i = gt; i < SG * TC * SH * 8; i += NT) {
          const int sub = i & 7, item = i >> 3, h = item & 15, d = (item >> 4) & 31, g = item >> 9;
          const float dt = expf(ldt_[g]);
          float acc[16];
#pragma unroll
          for (int j = 0; j < 16; ++j) acc[j] = 0.f;
          for (int pp = 0; pp < 8; ++pp) {
              const int p = sub * 8 + pp; const float lr = lre_[g * 64 + p], li = lim_[g * 64 + p];
              float pr, pi; cpow_lam(lr, li, dt, d, pr, pi);
              float cr, ci; zoh_coef(lr, li, dt, cr, ci);
              const float c_r = cre_[(g * 16 + h) * 64 + p], c_i = cim_[(g * 16 + h) * 64 + p];
              const float t_r = c_r * pr - c_i * pi, t_i = c_r * pi + c_i * pr;
              const float z_r = t_r * cr - t_i * ci, z_i = t_r * ci + t_i * cr;
#pragma unroll
              for (int j = 0; j < 16; ++j) acc[j] += z_r * bre_[(g * 64 + p) * 16 + j] - z_i * bim_[(g * 64 + p) * 16 + j];
          }
#pragma unroll
          for (int j = 0; j < 16; ++j) { float v = acc[j]; v += __shfl_xor(v, 1); v += __shfl_xor(v, 2); v += __shfl_xor(v, 4); acc[j] = v; }
          if (sub == 0) {
              if (d == 0) {
#pragma unroll
                  for (int j = 0; j < 16; ++j) if (j == h) acc[j] += sd_[g * 16 + h];
              }
              u32x4 w0, w1;
              w0.x = cvt_pk_bf16(acc[0], acc[1]); w0.y = cvt_pk_bf16(acc[2], acc[3]); w0.z = cvt_pk_bf16(acc[4], acc[5]); w0.w = cvt_pk_bf16(acc[6], acc[7]);
              w1.x = cvt_pk_bf16(acc[8], acc[9]); w1.y = cvt_pk_bf16(acc[10], acc[11]); w1.z = cvt_pk_bf16(acc[12], acc[13]); w1.w = cvt_pk_bf16(acc[14], acc[15]);
              bf16_t* dst = KK + ((size_t)(g * 32 + d) * 16 + h) * 32;
              *(u32x4*)dst = w0; *(u32x4*)(dst + 8) = w1;
              if (d < 31) { bf16_t* dn = KK + ((size_t)(g * 32 + d + 1) * 16 + h) * 32 + 16; *(u32x4*)dn = w0; *(u32x4*)(dn + 8) = w1; }
              if (d == 0) { *(u32x4*)(dst + 16) = (u32x4){0u, 0u, 0u, 0u}; *(u32x4*)(dst + 24) = (u32x4){0u, 0u, 0u, 0u}; }
          }
      } }
    { bf16_t* CC = (bf16_t*)(ws + WS_CCAR);
      for (int i = gt; i < SG * TC * SP; i += NT) {
          const int p = i & 63, t = (i >> 6) & 31, g = i >> 11;
          const float dt = expf(ldt_[g]); float pr, pi; cpow_lam(lre_[g * 64 + p], lim_[g * 64 + p], dt, t + 1, pr, pi);
          for (int h = 0; h < 16; ++h) { const float c_r = cre_[(g * 16 + h) * 64 + p], c_i = cim_[(g * 16 + h) * 64 + p];
              bf16_t* dst = CC + ((size_t)(g * 512 + 16 * t + h)) * 128;
              dst[p] = (bf16_t)(cvt_pk_bf16(c_r * pr - c_i * pi, 0.f) & 0xffffu); dst[64 + p] = (bf16_t)(cvt_pk_bf16(-(c_r * pi + c_i * pr), 0.f) & 0xffffu); }
      } }
    { bf16_t* BS = (bf16_t*)(ws + WS_BST);
      for (int i = gt; i < SG * SP * TC; i += NT) {
          const int s = i & 31, p = (i >> 5) & 63, g = i >> 11;
          const float dt = expf(ldt_[g]); const float lr = lre_[g * 64 + p], li = lim_[g * 64 + p];
          float pr, pi; cpow_lam(lr, li, dt, 31 - s, pr, pi); float cr, ci; zoh_coef(lr, li, dt, cr, ci);
          const float z_r = pr * cr - pi * ci, z_i = pr * ci + pi * cr;
          float vr[16], vi[16];
#pragma unroll
          for (int j = 0; j < 16; ++j) { const float b_r = bre_[(g * 64 + p) * 16 + j], b_i = bim_[(g * 64 + p) * 16 + j]; vr[j] = z_r * b_r - z_i * b_i; vi[j] = z_r * b_i + z_i * b_r; }
          bf16_t* d0 = BS + ((size_t)(g * 128 + p)) * 512 + s * 16; bf16_t* d1 = BS + ((size_t)(g * 128 + 64 + p)) * 512 + s * 16;
          u32x4 w;
          w.x = cvt_pk_bf16(vr[0], vr[1]); w.y = cvt_pk_bf16(vr[2], vr[3]); w.z = cvt_pk_bf16(vr[4], vr[5]); w.w = cvt_pk_bf16(vr[6], vr[7]); *(u32x4*)d0 = w;
          w.x = cvt_pk_bf16(vr[8], vr[9]); w.y = cvt_pk_bf16(vr[10], vr[11]); w.z = cvt_pk_bf16(vr[12], vr[13]); w.w = cvt_pk_bf16(vr[14], vr[15]); *(u32x4*)(d0 + 8) = w;
          w.x = cvt_pk_bf16(vi[0], vi[1]); w.y = cvt_pk_bf16(vi[2], vi[3]); w.z = cvt_pk_bf16(vi[4], vi[5]); w.w = cvt_pk_bf16(vi[6], vi[7]); *(u32x4*)d1 = w;
          w.x = cvt_pk_bf16(vi[8], vi[9]); w.y = cvt_pk_bf16(vi[10], vi[11]); w.z = cvt_pk_bf16(vi[12], vi[13]); w.w = cvt_pk_bf16(vi[14], vi[15]); *(u32x4*)(d1 + 8) = w;
      } }
    { float* LT = (float*)(ws + WS_LAMT);
      for (int i = gt; i < SG * SP; i += NT) { const int g = i >> 6; float pr, pi; cpow_lam(lre_[i], lim_[i], expf(ldt_[g]), TC, pr, pi); LT[2 * i] = pr; LT[2 * i + 1] = pi; } }
}

__device__ __forceinline__ unsigned off_b(unsigned row, unsigned ch) { return 256u * row + 16u * (ch ^ (((row & 3) << 2) | ((row >> 2) & 3))); }
__device__ __forceinline__ s16x4 tr_read(unsigned lds_addr) { s16x4 r; asm volatile("ds_read_b64_tr_b16 %0, %1\n\ts_waitcnt lgkmcnt(0)" : "=&v"(r) : "v"(lds_addr) : "memory"); return r; }

__device__ __forceinline__ void spatial_unit(const Args& args, LAS unsigned char* L, int b, int n, int g, int tid, int wid, int lane) {
    unsigned char* ws = args.ws;
    constexpr int VOFF = 0, WOFF = 32768, OOFF = 65536, SOFF = 100352;
    const int tok0 = b * SEQ + n * 128;
    const bf16_t* GV = (const bf16_t*)(ws + WS_GV); const bf16_t* Ub = (const bf16_t*)(ws + WS_U); bf16_t* Gb = (bf16_t*)(ws + WS_XB);
    const float* vstat = (const float*)(ws + WS_VSTAT); const bf16_t* WSPb = (const bf16_t*)(ws + WS_WSP) + (size_t)g * 16384;
    if (tid < 128) {
        const f32x4* p = (const f32x4*)(vstat + (size_t)(tok0 + tid) * 32);
        float s1 = 0.f, s2 = 0.f;
#pragma unroll
        for (int j = 0; j < 8; ++j) { const f32x4 v = p[j]; s1 += v[0] + v[2]; s2 += v[1] + v[3]; }
        const float mean = s1 * (1.0f / D), var = s2 * (1.0f / D) - mean * mean;
        *(LAS f32x2*)(L + SOFF + tid * 8) = (f32x2){mean, 1.0f / sqrtf(var + EPS)};
    }
    __syncthreads();
    const float* lvg = args.in[I_LVG] + g * 128; const float* lvb = args.in[I_LVB] + g * 128;
#pragma unroll
    for (int i = 0; i < 4; ++i) {
        const int q = tid + 512 * i, s = q >> 4, ch = q & 15;
        const u32x4 raw = *(const u32x4*)(GV + (size_t)(tok0 + s) * D + g * 128 + ch * 8);
        const f32x2 st = *(const LAS f32x2*)(L + SOFF + s * 8);
        const f32x4 g0 = *(const f32x4*)(lvg + ch * 8), g1 = *(const f32x4*)(lvg + ch * 8 + 4), b0 = *(const f32x4*)(lvb + ch * 8), b1 = *(const f32x4*)(lvb + ch * 8 + 4);
        u32x4 w;
        w.x = cvt_pk_bf16((bf_lo(raw.x) - st.x) * st.y * g0[0] + b0[0], (bf_hi(raw.x) - st.x) * st.y * g0[1] + b0[1]);
        w.y = cvt_pk_bf16((bf_lo(raw.y) - st.x) * st.y * g0[2] + b0[2], (bf_hi(raw.y) - st.x) * st.y * g0[3] + b0[3]);
        w.z = cvt_pk_bf16((bf_lo(raw.z) - st.x) * st.y * g1[0] + b1[0], (bf_hi(raw.z) - st.x) * st.y * g1[1] + b1[1]);
        w.w = cvt_pk_bf16((bf_lo(raw.w) - st.x) * st.y * g1[2] + b1[2], (bf_hi(raw.w) - st.x) * st.y * g1[3] + b1[3]);
        *(LAS u32x4*)(L + VOFF + off_b(s, ch)) = w;
        *(LAS u32x4*)(L + WOFF + off_b(s, ch)) = *(const u32x4*)(WSPb + (size_t)s * 128 + ch * 8);
    }
    __syncthreads();
    {
        const int cb = wid, gq = lane >> 4, q4 = (lane & 15) >> 2, p4 = lane & 3;
        const unsigned lbase = (unsigned)(size_t)(L + VOFF);
        bf16x8 vf[4];
#pragma unroll
        for (int ks = 0; ks < 4; ++ks) {
            const s16x4 lo = tr_read(lbase + off_b(32 * ks + 8 * gq + q4, 2 * cb + (p4 >> 1)) + 8 * (p4 & 1));
            const s16x4 hi = tr_read(lbase + off_b(32 * ks + 8 * gq + 4 + q4, 2 * cb + (p4 >> 1)) + 8 * (p4 & 1));
            vf[ks] = (bf16x8){lo[0], lo[1], lo[2], lo[3], hi[0], hi[1], hi[2], hi[3]};
        }
#pragma unroll
        for (int rb = 0; rb < 8; ++rb) {
            f32x4 acc = (f32x4){0.f, 0.f, 0.f, 0.f};
#pragma unroll
            for (int ks = 0; ks <= (rb >> 1); ++ks) {
                const bf16x8 wf = *(const LAS bf16x8*)(L + WOFF + off_b((lane & 15) + 16 * rb, 4 * ks + gq));
                acc = __builtin_amdgcn_mfma_f32_16x16x32_bf16(vf[ks], wf, acc, 0, 0, 0);
            }
            u32x2 w; w.x = cvt_pk_bf16(acc[0], acc[1]); w.y = cvt_pk_bf16(acc[2], acc[3]);
            *(LAS u32x2*)(L + OOFF + (16 * rb + (lane & 15)) * 272 + (16 * cb + 4 * gq) * 2) = w;
        }
    }
    __syncthreads();
    const float* bsp = args.in[I_BSP] + g * 128;
#pragma unroll
    for (int i = 0; i < 4; ++i) {
        const int q = tid + 512 * i, t = q >> 4, ch = q & 15;
        const u32x4 mx = *(const LAS u32x4*)(L + OOFF + t * 272 + ch * 16);
        const size_t off = (size_t)(tok0 + t) * D + g * 128 + ch * 8;
        const u32x4 uu = *(const u32x4*)(Ub + off);
        const float bb = bsp[t];
        u32x4 w;
        w.x = cvt_pk_bf16(bf_lo(uu.x) * (bf_lo(mx.x) + bb), bf_hi(uu.x) * (bf_hi(mx.x) + bb));
        w.y = cvt_pk_bf16(bf_lo(uu.y) * (bf_lo(mx.y) + bb), bf_hi(uu.y) * (bf_hi(mx.y) + bb));
        w.z = cvt_pk_bf16(bf_lo(uu.z) * (bf_lo(mx.z) + bb), bf_hi(uu.z) * (bf_hi(mx.z) + bb));
        w.w = cvt_pk_bf16(bf_lo(uu.w) * (bf_lo(mx.w) + bb), bf_hi(uu.w) * (bf_hi(mx.w) + bb));
        *(u32x4*)(Gb + off) = w;
    }
    __syncthreads();
}

__device__ __forceinline__ void ssm_unit(const Args& args, LAS unsigned char* L, int b, int g, int tid, int wid, int lane) {
    unsigned char* ws = args.ws;
    constexpr int UOFF = 0, USTR = 1040, SOFF = 66560, SSTR = 528, HOFF = 100352, HSTR = 272, KOFF = 117760;
    const bf16_t* ub = (const bf16_t*)(ws + WS_SB) + ((size_t)g * MP + (size_t)b * SEQ) * 16;
#pragma unroll
    for (int i = 0; i < 8; ++i) { const int q = tid + 512 * i, tok = q >> 1, half = q & 1;
        *(LAS u32x4*)(L + UOFF + (tok >> 5) * USTR + (tok & 31) * 32 + half * 16) = *(const u32x4*)(ub + (size_t)q * 8); }
    const bf16_t* kk = (const bf16_t*)(ws + WS_KK) + (size_t)g * 16384;
#pragma unroll
    for (int i = 0; i < 4; ++i) { const int q = tid + 512 * i; *(LAS u32x4*)(L + KOFF + q * 16) = *(const u32x4*)(kk + (size_t)q * 8); }
    __syncthreads();
    const int l15 = lane & 15, gq = lane >> 4;
    {
        const int rb = wid;
        f32x4 acc[4];
#pragma unroll
        for (int cb = 0; cb < 4; ++cb) acc[cb] = (f32x4){0.f, 0.f, 0.f, 0.f};
        const bf16_t* ap = (const bf16_t*)(ws + WS_BST) + ((size_t)(g * 128 + 16 * rb + l15)) * 512 + 8 * gq;
#pragma unroll 4
        for (int ks = 0; ks < 16; ++ks) {
            const bf16x8 a = *(const bf16x8*)(ap + 32 * ks);
#pragma unroll
            for (int cb = 0; cb < 4; ++cb) {
                const bf16x8 bf = *(const LAS bf16x8*)(L + UOFF + (16 * cb + l15) * USTR + (2 * ks + (gq >> 1)) * 32 + (gq & 1) * 16);
                acc[cb] = __builtin_amdgcn_mfma_f32_16x16x32_bf16(a, bf, acc[cb], 0, 0, 0);
            }
        }
#pragma unroll
        for (int cb = 0; cb < 4; ++cb) *(LAS f32x4*)(L + SOFF + (16 * cb + l15) * SSTR + (16 * rb + 4 * gq) * 4) = acc[cb];
    }
    __syncthreads();
    if (wid == 0) {
        const float* lt = (const float*)(ws + WS_LAMT) + (size_t)(g * 64 + lane) * 2;
        const float lr = lt[0], li = lt[1];
        float hr = 0.f, hi = 0.f;
#pragma unroll 8
        for (int n = 0; n < NCH; ++n) {
            *(LAS bf16_t*)(L + HOFF + n * HSTR + lane * 2) = (bf16_t)(cvt_pk_bf16(hr, 0.f) & 0xffffu);
            *(LAS bf16_t*)(L + HOFF + n * HSTR + (64 + lane) * 2) = (bf16_t)(cvt_pk_bf16(hi, 0.f) & 0xffffu);
            const float sr = *(const LAS float*)(L + SOFF + n * SSTR + lane * 4), si = *(const LAS float*)(L + SOFF + n * SSTR + (64 + lane) * 4);
            const float nr = lr * hr - li * hi + sr, ni = lr * hi + li * hr + si;
            hr = nr; hi = ni;
        }
        args.out[O_PRE + (size_t)(b * SG + g) * SP + lane] = hr;
        args.out[O_PIM + (size_t)(b * SG + g) * SP + lane] = hi;
    }
    f32x4 acc[4][4];
#pragma unroll
    for (int ti = 0; ti < 4; ++ti)
#pragma unroll
        for (int cb = 0; cb < 4; ++cb) acc[ti][cb] = (f32x4){0.f, 0.f, 0.f, 0.f};
#pragma unroll 2
    for (int s0 = 0; s0 < TC; s0 += 2) {
        bf16x8 bf[4];
#pragma unroll
        for (int cb = 0; cb < 4; ++cb) bf[cb] = *(const LAS bf16x8*)(L + UOFF + (16 * cb + l15) * USTR + (s0 + (gq >> 1)) * 32 + (gq & 1) * 16);
#pragma unroll
        for (int ti = 0; ti < 4; ++ti) {
            const int t = wid + 8 * ti;
            if (t >= s0) {
                const bf16x8 a = *(const LAS bf16x8*)(L + KOFF + (t - s0) * 1024 + l15 * 64 + gq * 16);
#pragma unroll
                for (int cb = 0; cb < 4; ++cb) acc[ti][cb] = __builtin_amdgcn_mfma_f32_16x16x32_bf16(a, bf[cb], acc[ti][cb], 0, 0, 0);
            }
        }
    }
    __syncthreads();
    {
        const bf16_t* cc = (const bf16_t*)(ws + WS_CCAR) + ((size_t)(g * 512 + l15)) * 128 + 8 * gq;
#pragma unroll
        for (int ks = 0; ks < 4; ++ks) {
            bf16x8 bf[4];
#pragma unroll
            for (int cb = 0; cb < 4; ++cb) bf[cb] = *(const LAS bf16x8*)(L + HOFF + (16 * cb + l15) * HSTR + ks * 64 + gq * 16);
#pragma unroll
            for (int ti = 0; ti < 4; ++ti) {
                const int t = wid + 8 * ti;
                const bf16x8 a = *(const bf16x8*)(cc + (size_t)(16 * t) * 128 + 32 * ks);
#pragma unroll
                for (int cb = 0; cb < 4; ++cb) acc[ti][cb] = __builtin_amdgcn_mfma_f32_16x16x32_bf16(a, bf[cb], acc[ti][cb], 0, 0, 0);
            }
        }
    }
    bf16_t* YS = (bf16_t*)(ws + WS_YS);
#pragma unroll
    for (int ti = 0; ti < 4; ++ti)
#pragma unroll
        for (int cb = 0; cb < 4; ++cb) {
            const int t = wid + 8 * ti, nn = 16 * cb + l15;
            u32x2 w; w.x = cvt_pk_bf16(acc[ti][cb][0], acc[ti][cb][1]); w.y = cvt_pk_bf16(acc[ti][cb][2], acc[ti][cb][3]);
            *(u32x2*)(YS + (size_t)(b * SEQ + 32 * nn + t) * SW + g * 16 + 4 * gq) = w;
        }
    __syncthreads();
}

__device__ __forceinline__ void sample_spatial_row(const Args& args, int i, int lane) {
    unsigned char* ws = args.ws; const int r = MPR + i;
    const float* vs = (const float*)(ws + WS_VSTAT) + (size_t)r * 32;
    float s1 = 0.f, s2 = 0.f;
#pragma unroll
    for (int j = 0; j < 16; ++j) { s1 += vs[2 * j]; s2 += vs[2 * j + 1]; }
    const float mean = s1 * (1.0f / D), rstd = 1.0f / sqrtf(s2 * (1.0f / D) - mean * mean + EPS);
    const bf16_t* GV = (const bf16_t*)(ws + WS_GV) + (size_t)r * D; const bf16_t* Ub = (const bf16_t*)(ws + WS_U) + (size_t)r * D; bf16_t* Gb = (bf16_t*)(ws + WS_XB) + (size_t)r * D;
#pragma unroll
    for (int j = 0; j < 4; ++j) {
        const int c = lane * 4 + 256 * j, g = c >> 7;
        const u32x2 gv = *(const u32x2*)(GV + c), uu = *(const u32x2*)(Ub + c);
        const f32x4 lg = *(const f32x4*)(args.in[I_LVG] + c), lb = *(const f32x4*)(args.in[I_LVB] + c);
        f32x4 vn;
        vn[0] = (bf_lo(gv.x) - mean) * rstd * lg[0] + lb[0]; vn[1] = (bf_hi(gv.x) - mean) * rstd * lg[1] + lb[1];
        vn[2] = (bf_lo(gv.y) - mean) * rstd * lg[2] + lb[2]; vn[3] = (bf_hi(gv.y) - mean) * rstd * lg[3] + lb[3];
        *(f32x4*)(args.out + O_CV + (size_t)i * D + c) = vn;
        const float w00 = args.in[I_WSP][(size_t)g * 16384], b0 = args.in[I_BSP][g * 128];
        u32x2 w;
        w.x = cvt_pk_bf16(bf_lo(uu.x) * (w00 * vn[0] + b0), bf_hi(uu.x) * (w00 * vn[1] + b0));
        w.y = cvt_pk_bf16(bf_lo(uu.y) * (w00 * vn[2] + b0), bf_hi(uu.y) * (w00 * vn[3] + b0));
        *(u32x2*)(Gb + c) = w;
    }
}
__device__ __forceinline__ void sample_ssm(const Args& args, int i, int g, int lane) {
    unsigned char* ws = args.ws; const int p = lane, r = MPR + i;
    const float lr = args.in[I_LRE][g * 64 + p], li = args.in[I_LIM][g * 64 + p], dt = expf(args.in[I_LDT][g]);
    float ar, ai; cpow_lam(lr, li, dt, 1, ar, ai);
    float cr, ci; zoh_coef(lr, li, dt, cr, ci);
    const bf16_t* up = (const bf16_t*)(ws + WS_SB) + ((size_t)g * MP + r) * 16;
    const u32x4 u0 = *(const u32x4*)up, u1 = *(const u32x4*)(up + 8);
    float uu[16];
    uu[0] = bf_lo(u0.x); uu[1] = bf_hi(u0.x); uu[2] = bf_lo(u0.y); uu[3] = bf_hi(u0.y); uu[4] = bf_lo(u0.z); uu[5] = bf_hi(u0.z); uu[6] = bf_lo(u0.w); uu[7] = bf_hi(u0.w);
    uu[8] = bf_lo(u1.x); uu[9] = bf_hi(u1.x); uu[10] = bf_lo(u1.y); uu[11] = bf_hi(u1.y); uu[12] = bf_lo(u1.z); uu[13] = bf_hi(u1.z); uu[14] = bf_lo(u1.w); uu[15] = bf_hi(u1.w);
    const float* bre = args.in[I_BRE] + (size_t)(g * 64 + p) * 16; const float* bim = args.in[I_BIM] + (size_t)(g * 64 + p) * 16;
    float br = 0.f, bi = 0.f;
#pragma unroll
    for (int j = 0; j < 16; ++j) { br += bre[j] * uu[j]; bi += bim[j] * uu[j]; }
    const float h0r = args.in[I_SRE][(size_t)(i * SG + g) * SP + p], h0i = args.in[I_SIM][(size_t)(i * SG + g) * SP + p];
    const float hr = ar * h0r - ai * h0i + (cr * br - ci * bi), hi = ar * h0i + ai * h0r + (cr * bi + ci * br);
    args.out[O_SRE + (size_t)(i * SG + g) * SP + p] = hr;
    args.out[O_SIM + (size_t)(i * SG + g) * SP + p] = hi;
    float mine = 0.f;
#pragma unroll
    for (int h = 0; h < 16; ++h) {
        float v = args.in[I_CRE][(size_t)(g * 16 + h) * 64 + p] * hr - args.in[I_CIM][(size_t)(g * 16 + h) * 64 + p] * hi;
        v = wave_sum(v);
        v += args.in[I_SD][g * 16 + h] * uu[h];
        if (lane == h) mine = v;
    }
    if (lane < 16) ((bf16_t*)(ws + WS_YS))[(size_t)r * SW + g * 16 + lane] = (bf16_t)(cvt_pk_bf16(mine, 0.f) & 0xffffu);
}

__global__ void __launch_bounds__(NTHR, 2) mega_fwd(Args args) {
    extern __shared__ __attribute__((aligned(16))) unsigned char lds[];
    LAS unsigned char* L = (LAS unsigned char*)lds;
    volatile LAS unsigned* MISC = (volatile LAS unsigned*)(L + LDSCTL_OFF + 320);
    const int tid = threadIdx.x, lane = tid & 63, wave = __builtin_amdgcn_readfirstlane(tid >> 6);
    const int G = gridDim.x; const int bx = blockIdx.x; const int vcu = (G % 8 == 0) ? (bx % 8) * (G / 8) + bx / 8 : bx;
    for (int u = tid; u < (LDS_BYTES - LDSCTL_OFF) / 4; u += NTHR) ((LAS unsigned*)(L + LDSCTL_OFF))[u] = 0u;
    __syncthreads();
    unsigned char* ws = args.ws;
    unsigned* ctl = (unsigned*)(ws + WS_CTL);
    const bool multi = (args.ph_hi - args.ph_lo) > 1;
    XcdBarrier bar; bar.bar = ctl + CW_BAR; bar.x = 0; bar.st = nullptr;
    if (multi) bar = xcd_barrier_post(ctl + CW_BAR, MISC + 8);
    const int lo = args.ph_lo, hi = args.ph_hi;
#define IN(k) (lo <= (k) && (k) < hi)
#define SEAM(k) do { if (IN(k) && IN((k) + 1)) xcd_barrier(bar); } while (0)

    if (IN(0)) { p0_prologue(args, L, vcu, G, tid, wave, lane); } SEAM(0);

    if (IN(1)) {
        pg8::Gemm g{(const bf16_t*)(ws + WS_XB), (const bf16_t*)(ws + WS_WIN), MP, NIN, D}; pg8::StaticOrder S; S.init(MP, NIN, G, bx);
        Epi1 E{(bf16_t*)(ws + WS_U), (bf16_t*)(ws + WS_GV), (bf16_t*)(ws + WS_SB), (bf16_t*)(ws + WS_SGA), (bf16_t*)(ws + WS_SGB), (const float*)(ws + WS_RSTD1), (float*)(ws + WS_VSTAT)};
        pg8::gemm_phase<Epi1, pg8::StaticOrder, true>(L, g, S, E);
    } SEAM(1);

    if (IN(2)) {
#ifndef DBG_SKIP_SSM
        for (int u = vcu; u < NB * SG; u += G) ssm_unit(args, L, u & 7, u >> 3, tid, wave, lane);
#endif
        for (int u = vcu; u < NB * 16 * 8; u += G) spatial_unit(args, L, (u >> 3) & 7, u >> 6, u & 7, tid, wave, lane);
        const int gw = vcu * NWAVES + wave, NGW = G * NWAVES;
        for (int i = gw; i < MSA; i += NGW) sample_spatial_row(args, i, lane);
        for (int q = gw; q < MSA * SG; q += NGW) sample_ssm(args, q >> 5, q & 31, lane);
    } SEAM(2);

    if (IN(3)) {
        pg8::Gemm g{(const bf16_t*)(ws + WS_YS), (const bf16_t*)(ws + WS_WB), MP, 2 * D, SW}; pg8::StaticOrder S; S.init(MP, 2 * D, G, bx);
        Epi3a E{(bf16_t*)(ws + WS_T2), (const bf16_t*)(ws + WS_SGB)};
        pg8::gemm_phase<Epi3a, pg8::StaticOrder, true>(L, g, S, E);
    } SEAM(3);

    if (IN(4)) {
        pg8::Gemm g{(const bf16_t*)(ws + WS_XB), (const bf16_t*)(ws + WS_WA), MP, D, D}; pg8::StaticOrder S; S.init(MP, D, G, bx);
        Epi3b E{(bf16_t*)(ws + WS_U), (const bf16_t*)(ws + WS_SGA), (const bf16_t*)(ws + WS_T2)};
        pg8::gemm_phase<Epi3b, pg8::StaticOrder, true>(L, g, S, E);
    } SEAM(4);

    if (IN(5)) {
        pg8::Gemm g{(const bf16_t*)(ws + WS_U), (const bf16_t*)(ws + WS_WO), MP, D, D}; pg8::StaticOrder S; S.init(MP, D, G, bx);
        Epi4 E{args.in[I_XP], args.in[I_XS], args.out, (bf16_t*)(ws + WS_GV), (float*)(ws + WS_RS2P)};
        pg8::gemm_phase<Epi4, pg8::StaticOrder, true>(L, g, S, E);
    } SEAM(5);

    if (IN(6)) {
        pg8::Gemm g{(const bf16_t*)(ws + WS_GV), (const bf16_t*)(ws + WS_WGU), MP, NGU, D}; pg8::StaticOrder S; S.init(MP, NGU, G, bx);
        Epi5 E{(bf16_t*)(ws + WS_SGA), (const float*)(ws + WS_RS2P)};
        pg8::gemm_phase<Epi5, pg8::StaticOrder, true>(L, g, S, E);
    } SEAM(6);

    if (IN(7)) {
        pg8::Gemm g{(const bf16_t*)(ws + WS_SGA), (const bf16_t*)(ws + WS_WD), MP, D, DFF}; pg8::StaticOrder S; S.init(MP, D, G, bx);
        Epi6 E{args.out, (float*)(ws + WS_RS3P)};
        pg8::gemm_phase<Epi6, pg8::StaticOrder, true>(L, g, S, E);
    } SEAM(7);

    if (IN(8)) {
        const int gw = vcu * NWAVES + wave, NGW = G * NWAVES;
        const float* rsp = (const float*)(ws + WS_RS3P); const f32x4* gf = (const f32x4*)args.in[I_GF] + lane;
        for (int m = gw; m < MREAL; m += NGW) {
            const f32x4* p = (const f32x4*)(rsp + (size_t)m * 16);
            const f32x4 a = p[0], b = p[1], c = p[2], d = p[3];
            const float s = ((a[0] + a[1]) + (a[2] + a[3])) + ((b[0] + b[1]) + (b[2] + b[3])) + ((c[0] + c[1]) + (c[2] + c[3])) + ((d[0] + d[1]) + (d[2] + d[3]));
            const float r = 1.0f / sqrtf(s * (1.0f / D) + EPS);
            f32x4* xr = (f32x4*)(args.out + (size_t)m * D) + lane;
#pragma unroll
            for (int j = 0; j < 4; ++j) xr[64 * j] = xr[64 * j] * r * gf[64 * j];
        }
    }
#ifdef DBG_DUMP
    if (IN(9)) {
        const bf16_t* src = (const bf16_t*)(ws + (DBG_DUMP == 1 ? WS_XB : DBG_DUMP == 2 ? WS_YS : DBG_DUMP == 3 ? WS_T2 : DBG_DUMP == 5 ? WS_GV : WS_U));
        const size_t n = (DBG_DUMP == 2) ? (size_t)MREAL * SW : (size_t)MREAL * D;
        for (size_t i = (size_t)bx * NTHR + tid; i < (size_t)MREAL * D; i += (size_t)G * NTHR) {
            float v = i < n ? bf1(src[i]) : 0.f;
            if (DBG_DUMP == 6) v = i < (size_t)MREAL * 32 ? ((const float*)(ws + WS_VSTAT))[i] : 0.f;
            if (!(v == v) || fabsf(v) > 1e30f) v = 1e30f;
            args.out[i] = v;
        }
    }
#endif
#undef IN
#undef SEAM
}

#ifndef MK_N_LAUNCHES
#define MK_N_LAUNCHES 1
#endif
extern "C" void kernel_launch(void* const* d_in, const int* in_sizes, int n_in, void* d_out, int out_size, void* d_ws, size_t ws_size, hipStream_t stream) {
    static int grid = 0;
    if (grid == 0) {
        int dev = 0, cus = 0, per_cu = 0;
        if (n_in != 26 || out_size != 17596416 || ws_size < WS_END) { fprintf(stderr, "kernel_launch: unexpected sizes n_in %d out %d ws %zu (need %zu)\n", n_in, out_size, ws_size, (size_t)WS_END); grid = -1; return; }
        if (hipGetDevice(&dev) != hipSuccess || hipDeviceGetAttribute(&cus, hipDeviceAttributeMultiprocessorCount, dev) != hipSuccess) { fprintf(stderr, "kernel_launch: device query failed\n"); grid = -1; return; }
        if (hipFuncSetAttribute((const void*)mega_fwd, hipFuncAttributeMaxDynamicSharedMemorySize, LDS_BYTES) != hipSuccess) { fprintf(stderr, "kernel_launch: hipFuncSetAttribute failed\n"); grid = -1; return; }
        if (hipOccupancyMaxActiveBlocksPerMultiprocessor(&per_cu, (const void*)mega_fwd, NTHR, LDS_BYTES) != hipSuccess || per_cu < 1) { fprintf(stderr, "kernel_launch: occupancy query says %d blocks per CU\n", per_cu); (void)hipGetLastError(); grid = -1; return; }
        (void)hipGetLastError();
        grid = cus;
    }
    if (grid < 0) return;
    (void)hipMemsetAsync((char*)d_ws + WS_CTL, 0, CTL_ZERO_BYTES, stream);
    Args a{};
    for (int i = 0; i < 26; ++i) a.in[i] = (const float*)d_in[i];
    a.out = (float*)d_out; a.ws = (unsigned char*)d_ws;
    if (MK_N_LAUNCHES == 1) { a.ph_lo = 0; a.ph_hi = 9; hipLaunchKernelGGL(mega_fwd, dim3(grid), dim3(NTHR), LDS_BYTES, stream, a); }
    else { for (int p = 0; p < DBG_NPH; ++p) { a.ph_lo = (p == DBG_NPH - 1 && DBG_LASTPH >= 0) ? DBG_LASTPH : p; a.ph_hi = a.ph_lo + 1; hipLaunchKernelGGL(mega_fwd, dim3(grid), dim3(NTHR), LDS_BYTES, stream, a); } }
}
```

```cpp
#include <hip/hip_runtime.h>
#include <cstdio>
#include <cstdint>
#define DBG_NPH 9
#define DBG_LASTPH -1

#define GAS __attribute__((address_space(1)))
#define LAS __attribute__((address_space(3)))
typedef unsigned short bf16_t;
typedef short bf16x8 __attribute__((ext_vector_type(8)));
typedef short s16x4 __attribute__((ext_vector_type(4)));
typedef float f32x4 __attribute__((ext_vector_type(4)));
typedef float f32x2 __attribute__((ext_vector_type(2)));
typedef unsigned u32x4 __attribute__((ext_vector_type(4)));
typedef unsigned u32x2 __attribute__((ext_vector_type(2)));

constexpr int D = 1024, MPR = 16384, MSA = 128, MREAL = MPR + MSA, MP = 16640;
constexpr int NIN = 4608, DFF = 2816, SW = 512, NGU = 2 * DFF, SEQ = 2048, NB = 8;
constexpr int SG = 32, SP = 64, SH = 16, TC = 32, NCH = SEQ / TC;
constexpr float EPS = 1e-6f;
constexpr int NWAVES = 8, NTHR = 512;
constexpr int LDS_BYTES = 163840, LDSCTL_OFF = 162816;

constexpr size_t O_Y = 0, O_PRE = 16908288, O_PIM = 16924672, O_SRE = 16941056, O_SIM = 17203200, O_CV = 17465344;

constexpr size_t A34 = (size_t)MP * D * 2, A17 = (size_t)MP * SW * 2;
constexpr size_t WS_CTL = 0, CTL_ZERO_BYTES = 1u << 20;
constexpr size_t WS_WIN = 1u << 20;
constexpr size_t WS_WA = WS_WIN + (size_t)NIN * D * 2;
constexpr size_t WS_WB = WS_WA + (size_t)D * D * 2;
constexpr size_t WS_WO = WS_WB + (size_t)2 * D * SW * 2;
constexpr size_t WS_WGU = WS_WO + (size_t)D * D * 2;
constexpr size_t WS_WD = WS_WGU + (size_t)NGU * D * 2;
constexpr size_t WS_WSP = WS_WD + (size_t)D * DFF * 2;
constexpr size_t WS_KK = WS_WSP + 8 * 128 * 128 * 2;
constexpr size_t WS_CCAR = WS_KK + (size_t)SG * TC * SH * 32 * 2;
constexpr size_t WS_BST = WS_CCAR + (size_t)SG * 512 * 128 * 2;
constexpr size_t WS_LAMT = WS_BST + (size_t)SG * 128 * 512 * 2;
constexpr size_t WS_RSTD1 = WS_LAMT + SG * SP * 2 * 4;
constexpr size_t WS_VSTAT = WS_RSTD1 + (size_t)MP * 4;
constexpr size_t WS_RS2P = WS_VSTAT + (size_t)MP * 32 * 4;
constexpr size_t WS_RS3P = WS_RS2P + (size_t)MP * 16 * 4;
constexpr size_t WS_VSTS = WS_RS3P + (size_t)MP * 16 * 4;
constexpr size_t WS_RS2S = WS_VSTS + 128 * 64 * 2 * 4;
constexpr size_t WS_RS3S = WS_RS2S + 128 * 64 * 4;
constexpr size_t WS_TAB_END = WS_RS3S + 128 * 64 * 4;
constexpr size_t WS_U = 48u << 20;
constexpr size_t WS_GV = WS_U + A34;
constexpr size_t WS_SB = WS_GV + A34;
constexpr size_t WS_YS = WS_SB + A17;
constexpr size_t WS_SGA = WS_YS + A17;
constexpr size_t WS_SGB = WS_SGA + A34;
constexpr size_t WS_XB = WS_SGB + A34;
constexpr size_t WS_T2 = WS_GV;
constexpr size_t WS_END = WS_XB + A34;
static_assert(WS_TAB_END <= WS_U, "tables fit under 48 MiB");
static_assert(WS_END <= 268435456ull, "d_ws map fits 256 MiB");
static_assert((size_t)MP * DFF * 2 <= 3 * A34, "H overlay fits");
constexpr int CW_BAR = 4096;

typedef __bf16 bf16x2_t __attribute__((ext_vector_type(2)));
__device__ __forceinline__ unsigned cvt_pk_bf16(float lo, float hi) { const bf16x2_t r = __builtin_convertvector((f32x2){lo, hi}, bf16x2_t); return __builtin_bit_cast(unsigned, r); }
__device__ __forceinline__ float bf_lo(unsigned w) { return __uint_as_float(w << 16); }
__device__ __forceinline__ float bf_hi(unsigned w) { return __uint_as_float(w & 0xffff0000u); }
__device__ __forceinline__ float bf1(bf16_t h) { return __uint_as_float(((unsigned)h) << 16); }
__device__ __forceinline__ float fast_sigmoid(float x) { return __builtin_amdgcn_rcpf(1.0f + __builtin_amdgcn_exp2f(-1.4426950408889634f * x)); }
__device__ __forceinline__ float gelu_tanh(float x) { const float t = 1.5957691216057308f * (x + 0.044715f * x * x * x); return x * fast_sigmoid(t); }
__device__ __forceinline__ float wave_sum(float v) {
#pragma unroll
    for (int o = 1; o < 64; o <<= 1) v += __shfl_xor(v, o);
    return v;
}

#define XB_TMO      128
#define XB_XCNT(j)  (256  + 64 * (j))
#define XB_XSUB(j)  (1280 + 64 * (j))
#define XB_XGEN(j)  (2304 + 64 * (j))
#define XB_TOP      3328
#define XB_TOPGEN   3392
#define XCD_BAR_WORDS 3456
#define XB_SPIN_CAP (1u << 18)
__device__ __forceinline__ unsigned xb_ld(unsigned* p)              { return __hip_atomic_load(p, __ATOMIC_RELAXED, __HIP_MEMORY_SCOPE_AGENT); }
__device__ __forceinline__ unsigned xb_add(unsigned* p, unsigned v) { return __hip_atomic_fetch_add(p, v, __ATOMIC_RELAXED, __HIP_MEMORY_SCOPE_AGENT); }
__device__ __forceinline__ unsigned xb_xcc_id() { return (unsigned)__builtin_amdgcn_s_getreg((3 << 11) | 20) & 0xFu; }
#define XB_SPIN(cond, bar) do { unsigned _sp = 0; while (cond) { __builtin_amdgcn_s_sleep(1); \
    if ((++_sp & 255u) == 0u) { if (xb_ld(&(bar)[XB_TMO])) break; if (_sp > XB_SPIN_CAP) { atomicAdd(&(bar)[XB_TMO], 1u); break; } } } } while (0)
struct XcdBarrier { unsigned* bar; unsigned x; volatile LAS unsigned* st; };
__device__ __forceinline__ XcdBarrier xcd_barrier_post(unsigned* bar, volatile LAS unsigned* st) {
    XcdBarrier b; b.bar = bar; b.x = xb_xcc_id(); b.st = st;
    if (threadIdx.x == 0) (void)xb_add(&bar[XB_XCNT(b.x)], 1u);
    return b;
}
__device__ __forceinline__ void xcd_barrier_complete(unsigned* bar, unsigned x, unsigned& nloc, unsigned& nx) {
    const unsigned G = gridDim.x * gridDim.y * gridDim.z;
    unsigned sum, cnt, mine, sp = 0u;
    for (;;) {
        sum = 0u; cnt = 0u; mine = 0u;
#pragma unroll
        for (unsigned j = 0; j < 16; ++j) { const unsigned c = xb_ld(&bar[XB_XCNT(j)]); sum += c; cnt += (c > 0u) ? 1u : 0u; mine = (j == x) ? c : mine; }
        if (sum == G) break;
        __builtin_amdgcn_s_sleep(1);
        if ((++sp & 255u) == 0u) { if (xb_ld(&bar[XB_TMO])) break; if (sp > XB_SPIN_CAP) { atomicAdd(&bar[XB_TMO], 1u); break; } }
    }
    nloc = mine > 0u ? mine : 1u; nx = cnt > 0u ? cnt : 1u;
}
__device__ __forceinline__ void xcd_barrier(const XcdBarrier& b) {
    asm volatile("s_waitcnt vmcnt(0)" ::: "memory");
    __syncthreads();
    if (threadIdx.x == 0) {
        unsigned* bar = b.bar;
        __builtin_amdgcn_s_waitcnt(0);
        unsigned nloc = b.st[0], nx = b.st[1];
        if (nloc == 0u) { xcd_barrier_complete(bar, b.x, nloc, nx); b.st[0] = nloc; b.st[1] = nx; }
        const unsigned old = xb_add(&bar[XB_XSUB(b.x)], 1u);
        const unsigned gen = old / nloc;
        if (old + 1u == (gen + 1u) * nloc) {
            __builtin_amdgcn_fence(__ATOMIC_RELEASE, "agent");
            asm volatile("s_waitcnt vmcnt(0)" ::: "memory");
            const unsigned og = xb_add(&bar[XB_TOP], 1u);
            const unsigned tg = og / nx;
            if (og + 1u == (tg + 1u) * nx) xb_add(&bar[XB_TOPGEN], 1u);
            else XB_SPIN(xb_ld(&bar[XB_TOPGEN]) == tg, bar);
            __builtin_amdgcn_fence(__ATOMIC_ACQUIRE, "agent");
            xb_add(&bar[XB_XGEN(b.x)], 1u);
            asm volatile("s_waitcnt vmcnt(0)" ::: "memory");
        } else {
            XB_SPIN(xb_ld(&bar[XB_XGEN(b.x)]) == gen, bar);
            __builtin_amdgcn_fence(__ATOMIC_ACQUIRE, "agent");
            asm volatile("s_waitcnt vmcnt(0)" ::: "memory");
        }
    }
    __syncthreads();
}

namespace pg8 {
constexpr int BM = 256, BK = 64, HALF = 128, HTB = HALF * BK * 2, STAGE_BYTES = 8 * HTB, NXCD = 8, WGM = 8;
__host__ __device__ __forceinline__ int lds_byte(int r, int c) { const int st = (r >> 4) * 2 + (c >> 5), rr = r & 15, cc = c & 31, ob = rr * 64 + cc * 2; return st * 1024 + (ob ^ (((ob >> 9) & 1) << 5)); }
__host__ __device__ __forceinline__ void stage_rc(int b, int& R, int& C) { const int st = b / 1024, sb = b % 1024, swz = sb ^ (((sb >> 9) & 1) << 5); R = (st >> 1) * 16 + swz / 64; C = (st & 1) * 32 + (swz % 64) / 2; }
__host__ __device__ __forceinline__ int perm32(int rho) { const int n = rho >> 4, i = rho & 15; return 8 * (i >> 2) + 4 * n + (i & 3); }
struct Unit { int pm, pn; };
struct Gemm { const bf16_t* A; const bf16_t* Bt; int M, N, K; };
struct StaticOrder {
    int nM, nN, nwg, G, c;
    __host__ __device__ void init(int M, int N, int G_, int c_) { nM = M / BM; nN = N / BM; nwg = nM * nN; G = G_; c = c_; }
    __host__ __device__ bool next(int i, Unit& u) const {
        const long L = (long)i * G + c; if (L >= nwg) return false;
        int wgid = (int)L; { const int q = nwg / NXCD, r = nwg % NXCD, xcd = wgid % NXCD, off = wgid / NXCD; wgid = (xcd < r ? xcd * (q + 1) : r * (q + 1) + (xcd - r) * q) + off; }
        const int nig = WGM * nN, gid = wgid / nig, fm = gid * WGM, gsz = (nM - fm) < WGM ? (nM - fm) : WGM;
        u.pm = fm + ((wgid % nig) % gsz); u.pn = (wgid % nig) / gsz; return true;
    }
    __device__ __forceinline__ void a_ready(const Unit&) const {}
    __device__ __forceinline__ void done(const Unit&) const {}
};

template <class Epi, class Sched, bool ALIGN_EPI = true>
__device__ __forceinline__ void gemm_phase(LAS unsigned char* lds, const Gemm g, const Sched& S, const Epi& E) {
    const int tid = threadIdx.x, wid = __builtin_amdgcn_readfirstlane(tid >> 6), lane = tid & 63, wr = wid >> 2, wc = wid & 3, fr = lane & 15, fq = lane >> 4;
    const int K = g.K, nt = K / BK;
    unsigned voffA[2], voffB[2];
#pragma unroll
    for (int i = 0; i < 2; ++i) { int R, C; stage_rc(tid * 16 + i * 8192, R, C); const int Rb = Epi::PERM ? ((R & ~31) + perm32(R & 31)) : R;
        voffA[i] = (unsigned)(R * K + C) * 2u; voffB[i] = (unsigned)(Rb * K + C) * 2u; }
    const size_t kstep = (size_t)(BK * 2);
    const size_t hstep = (size_t)HALF * K * 2;
    const size_t tstep = 2 * hstep;
    const unsigned ldsw = (unsigned)wid * 1024u;
    const int aoff = lds_byte(wr * 64 + fr, fq * 8), boff = lds_byte(wc * 32 + fr, fq * 8);
#define PG8_SA(b, h) (((b) * 2 + (h)) * HTB)
#define PG8_SB(b, h) ((4 + (b) * 2 + (h)) * HTB)
#define PG8_STAGE(bufoff, gbase, voff) do { _Pragma("unroll") for (int _i = 0; _i < 2; ++_i) \
        __builtin_amdgcn_global_load_lds((const unsigned*)((const char*)(gbase) + (voff)[_i]), (LAS unsigned*)(lds + (bufoff) + ldsw + _i * 8192), 16, 0, 0); } while (0)
#define PG8_LDA(dst, b, h) do { _Pragma("unroll") for (int m = 0; m < 4; ++m) _Pragma("unroll") for (int k = 0; k < 2; ++k) dst[m][k] = *(const LAS bf16x8*)(lds + PG8_SA(b, h) + aoff + m * 2048 + k * 1024); } while (0)
#define PG8_LDB(dst, b, h) do { _Pragma("unroll") for (int n = 0; n < 2; ++n) _Pragma("unroll") for (int k = 0; k < 2; ++k) dst[n][k] = *(const LAS bf16x8*)(lds + PG8_SB(b, h) + boff + n * 2048 + k * 1024); } while (0)
#define PG8_MMA(ai, bj, At, Bt) do { __builtin_amdgcn_s_setprio(1); _Pragma("unroll") for (int m = 0; m < 4; ++m) _Pragma("unroll") for (int n = 0; n < 2; ++n) _Pragma("unroll") for (int k = 0; k < 2; ++k) \
        acc[ai][bj][m][n] = __builtin_amdgcn_mfma_f32_16x16x32_bf16(Bt[n][k], At[m][k], acc[ai][bj][m][n], 0, 0, 0); __builtin_amdgcn_s_setprio(0); } while (0)
#define PG8_WAIT_V(n) asm volatile("s_waitcnt vmcnt(" #n ")" ::: "memory")
#define PG8_WAIT_L(n) asm volatile("s_waitcnt lgkmcnt(" #n ")" ::: "memory")
#define PG8_BAR __builtin_amdgcn_s_barrier()
#define PG8_SCHED __builtin_amdgcn_sched_barrier(0)
    Unit cur, nxt; int ui = 0;
    if (!S.next(0, cur)) return;
    f32x4 acc[2][2][4][2];
#pragma unroll
    for (int a = 0; a < 2; ++a)
#pragma unroll
        for (int b = 0; b < 2; ++b)
#pragma unroll
            for (int m = 0; m < 4; ++m)
#pragma unroll
                for (int n = 0; n < 2; ++n) acc[a][b][m][n] = (f32x4){0.f, 0.f, 0.f, 0.f};
    bf16x8 At[4][2], B0[2][2], B1[2][2];
    const char* cA = (const char*)g.A + (size_t)cur.pm * tstep; const char* cB = (const char*)g.Bt + (size_t)cur.pn * tstep;
    S.a_ready(cur);
    PG8_STAGE(PG8_SB(0, 0), cB, voffB); PG8_STAGE(PG8_SB(0, 1), cB + hstep, voffB); PG8_STAGE(PG8_SA(0, 0), cA, voffA); PG8_STAGE(PG8_SA(0, 1), cA + hstep, voffA);
    if (wr == 1) PG8_BAR;
    PG8_WAIT_V(2); PG8_BAR;
    PG8_STAGE(PG8_SB(1, 0), cB + kstep, voffB); PG8_STAGE(PG8_SA(1, 0), cA + kstep, voffA); PG8_STAGE(PG8_SB(1, 1), cB + hstep + kstep, voffB);
    PG8_WAIT_V(6); PG8_BAR;
    for (;;) {
        const bool has_next = S.next(ui + 1, nxt);
        const char* nA = has_next ? (const char*)g.A + (size_t)nxt.pm * tstep : cA; const char* nB = has_next ? (const char*)g.Bt + (size_t)nxt.pn * tstep : cB;
        for (int t = 0; t < nt; t += 2) {
            const bool last = (t == nt - 2);
            const char* a1 = cA + (size_t)(t + 1) * kstep;
            const char* a2 = last ? nA : cA + (size_t)(t + 2) * kstep; const char* b2 = last ? nB : cB + (size_t)(t + 2) * kstep;
            const char* a3 = a2 + kstep; const char* b3 = b2 + kstep;
            if (last && has_next) S.a_ready(nxt);
            PG8_LDB(B0, 0, 0); PG8_LDB(B1, 0, 1); PG8_SCHED; PG8_LDA(At, 0, 0); PG8_STAGE(PG8_SA(1, 1), a1 + hstep, voffA);
            PG8_WAIT_V(8); PG8_WAIT_L(0); PG8_BAR; PG8_MMA(0, 0, At, B0); PG8_MMA(0, 1, At, B1); PG8_BAR; PG8_SCHED;
            PG8_LDA(At, 0, 1); PG8_STAGE(PG8_SB(0, 0), b2, voffB); PG8_STAGE(PG8_SB(0, 1), b2 + hstep, voffB); PG8_STAGE(PG8_SA(0, 0), a2, voffA);
            PG8_WAIT_V(8); PG8_WAIT_L(0); PG8_BAR; PG8_MMA(1, 0, At, B0); PG8_MMA(1, 1, At, B1); PG8_BAR; PG8_SCHED;
            PG8_LDB(B0, 1, 0); PG8_LDB(B1, 1, 1); PG8_SCHED; PG8_LDA(At, 1, 0); PG8_STAGE(PG8_SA(0, 1), a2 + hstep, voffA);
            PG8_WAIT_V(8); PG8_WAIT_L(0); PG8_BAR; PG8_MMA(0, 0, At, B0); PG8_MMA(0, 1, At, B1); PG8_BAR; PG8_SCHED;
            PG8_LDA(At, 1, 1); PG8_STAGE(PG8_SB(1, 0), b3, voffB); PG8_STAGE(PG8_SB(1, 1), b3 + hstep, voffB); PG8_STAGE(PG8_SA(1, 0), a3, voffA);
            PG8_WAIT_V(8); PG8_WAIT_L(0); PG8_BAR; PG8_MMA(1, 0, At, B0); PG8_MMA(1, 1, At, B1); PG8_BAR; PG8_SCHED;
        }
        if constexpr (ALIGN_EPI) { if (wr == 0) PG8_BAR; }
        E(acc, cur, wr, wc, fr, fq, lane); S.done(cur);
        if (!has_next) break;
#pragma unroll
        for (int a = 0; a < 2; ++a)
#pragma unroll
            for (int b = 0; b < 2; ++b)
#pragma unroll
                for (int m = 0; m < 4; ++m)
#pragma unroll
                    for (int n = 0; n < 2; ++n) acc[a][b][m][n] = (f32x4){0.f, 0.f, 0.f, 0.f};
        cur = nxt; cA = nA; cB = nB; ++ui;
        if constexpr (ALIGN_EPI) { if (wr == 1) PG8_BAR; }
    }
    PG8_WAIT_V(0);
    if constexpr (!ALIGN_EPI) { if (wr == 0) PG8_BAR; }
    PG8_BAR;
#undef PG8_SA
#undef PG8_SB
#undef PG8_STAGE
#undef PG8_LDA
#undef PG8_LDB
#undef PG8_MMA
#undef PG8_WAIT_V
#undef PG8_WAIT_L
#undef PG8_BAR
#undef PG8_SCHED
}
}
using pg8::Unit;

typedef f32x4 AccT[2][2][4][2];

__device__ __forceinline__ void fetch_rowscale(const float* P16, int pm, int wr, int lane, int fr, float (&rs)[2][4]) {
    float v[2];
#pragma unroll
    for (int ai = 0; ai < 2; ++ai) {
        const f32x4* p = (const f32x4*)(P16 + (size_t)(pm * 256 + ai * 128 + wr * 64 + lane) * 16);
        const f32x4 a = p[0], b = p[1], c = p[2], d = p[3];
        const float s = ((a[0] + a[1]) + (a[2] + a[3])) + ((b[0] + b[1]) + (b[2] + b[3])) + ((c[0] + c[1]) + (c[2] + c[3])) + ((d[0] + d[1]) + (d[2] + d[3]));
        v[ai] = __builtin_amdgcn_rsqf(s * (1.0f / D) + EPS);
    }
#pragma unroll
    for (int ai = 0; ai < 2; ++ai)
#pragma unroll
        for (int m = 0; m < 4; ++m) rs[ai][m] = __shfl(v[ai], m * 16 + fr);
}

struct Epi1 {
    static constexpr bool PERM = true;
    bf16_t *U, *GV, *SB, *SGA, *SGB; const float* rstd; float* vstat;
    __device__ __forceinline__ void operator()(const AccT& acc, const Unit& u, int wr, int wc, int fr, int fq, int lane) const {
        const int row0 = u.pm * 256 + wr * 64 + fr, pn = u.pn;
        const int type = pn < 4 ? 0 : pn < 8 ? 1 : pn < 10 ? 2 : pn < 14 ? 3 : 4;
        const int pnl = pn - (type == 0 ? 0 : type == 1 ? 4 : type == 2 ? 8 : type == 3 ? 10 : 14);
        bf16_t* base = type == 0 ? U : type == 1 ? GV : type == 3 ? SGA : SGB;
#pragma unroll
        for (int ai = 0; ai < 2; ++ai)
#pragma unroll
            for (int m = 0; m < 4; ++m) {
                const int row = row0 + ai * 128 + m * 16; const float rs = rstd[row];
                float s1 = 0.f, s2 = 0.f;
#pragma unroll
                for (int bj = 0; bj < 2; ++bj) {
                    f32x4 v0 = acc[ai][bj][m][0] * rs, v1 = acc[ai][bj][m][1] * rs;
                    const int col = pnl * 256 + bj * 128 + wc * 32 + 8 * fq;
                    if (type <= 1) {
#pragma unroll
                        for (int j = 0; j < 4; ++j) { v0[j] = gelu_tanh(v0[j]); v1[j] = gelu_tanh(v1[j]); }
                        if (type == 1) {
#pragma unroll
                            for (int j = 0; j < 4; ++j) { s1 += v0[j] + v1[j]; s2 += v0[j] * v0[j] + v1[j] * v1[j]; }
                        }
                    } else if (type >= 3) {
#pragma unroll
                        for (int j = 0; j < 4; ++j) { v0[j] = fast_sigmoid(v0[j]); v1[j] = fast_sigmoid(v1[j]); }
                    }
                    u32x4 w; w.x = cvt_pk_bf16(v0[0], v0[1]); w.y = cvt_pk_bf16(v0[2], v0[3]); w.z = cvt_pk_bf16(v1[0], v1[1]); w.w = cvt_pk_bf16(v1[2], v1[3]);
                    if (type == 2) *(u32x4*)(SB + ((size_t)(col >> 4) * MP + row) * 16 + (col & 15)) = w;
                    else *(u32x4*)(base + (size_t)row * D + col) = w;
                }
                if (type == 1) {
                    s1 += __shfl_xor(s1, 16); s1 += __shfl_xor(s1, 32); s2 += __shfl_xor(s2, 16); s2 += __shfl_xor(s2, 32);
                    if (fq == 0) *(f32x2*)(vstat + ((size_t)row * 16 + pnl * 4 + wc) * 2) = (f32x2){s1, s2};
                }
            }
    }
};
struct Epi3a {
    static constexpr bool PERM = true;
    bf16_t* T2; const bf16_t* SGB;
    __device__ __forceinline__ void operator()(const AccT& acc, const Unit& u, int wr, int wc, int fr, int fq, int lane) const {
        const int row0 = u.pm * 256 + wr * 64 + fr, col = u.pn * 128 + wc * 32 + 8 * fq;
#pragma unroll
        for (int ai = 0; ai < 2; ++ai)
#pragma unroll
            for (int m = 0; m < 4; ++m) {
                const size_t off = (size_t)(row0 + ai * 128 + m * 16) * D + col;
                const u32x4 sg = *(const u32x4*)(SGB + off);
                const f32x4 a0 = acc[ai][0][m][0], a1 = acc[ai][0][m][1], g0 = acc[ai][1][m][0], g1 = acc[ai][1][m][1];
                u32x4 w;
                w.x = cvt_pk_bf16(bf_lo(sg.x) * a0[0] * fast_sigmoid(g0[0]), bf_hi(sg.x) * a0[1] * fast_sigmoid(g0[1]));
                w.y = cvt_pk_bf16(bf_lo(sg.y) * a0[2] * fast_sigmoid(g0[2]), bf_hi(sg.y) * a0[3] * fast_sigmoid(g0[3]));
                w.z = cvt_pk_bf16(bf_lo(sg.z) * a1[0] * fast_sigmoid(g1[0]), bf_hi(sg.z) * a1[1] * fast_sigmoid(g1[1]));
                w.w = cvt_pk_bf16(bf_lo(sg.w) * a1[2] * fast_sigmoid(g1[2]), bf_hi(sg.w) * a1[3] * fast_sigmoid(g1[3]));
                *(u32x4*)(T2 + off) = w;
            }
    }
};
struct Epi3b {
    static constexpr bool PERM = true;
    bf16_t* MG; const bf16_t* SGA; const bf16_t* T2;
    __device__ __forceinline__ void operator()(const AccT& acc, const Unit& u, int wr, int wc, int fr, int fq, int lane) const {
        const int row0 = u.pm * 256 + wr * 64 + fr, col0 = u.pn * 256 + wc * 32 + 8 * fq;
#pragma unroll
        for (int ai = 0; ai < 2; ++ai)
#pragma unroll
            for (int m = 0; m < 4; ++m)
#pragma unroll
                for (int bj = 0; bj < 2; ++bj) {
                    const size_t off = (size_t)(row0 + ai * 128 + m * 16) * D + col0 + bj * 128;
                    const u32x4 sg = *(const u32x4*)(SGA + off), t2 = *(const u32x4*)(T2 + off);
                    const f32x4 a0 = acc[ai][bj][m][0], a1 = acc[ai][bj][m][1];
                    u32x4 w;
                    w.x = cvt_pk_bf16(bf_lo(sg.x) * a0[0] + bf_lo(t2.x), bf_hi(sg.x) * a0[1] + bf_hi(t2.x));
                    w.y = cvt_pk_bf16(bf_lo(sg.y) * a0[2] + bf_lo(t2.y), bf_hi(sg.y) * a0[3] + bf_hi(t2.y));
                    w.z = cvt_pk_bf16(bf_lo(sg.z) * a1[0] + bf_lo(t2.z), bf_hi(sg.z) * a1[1] + bf_hi(t2.z));
                    w.w = cvt_pk_bf16(bf_lo(sg.w) * a1[2] + bf_lo(t2.w), bf_hi(sg.w) * a1[3] + bf_hi(t2.w));
                    *(u32x4*)(MG + off) = w;
                }
    }
};
struct Epi4 {
    static constexpr bool PERM = false;
    const float *xp, *xs; float* out; bf16_t* XN; float* rsp;
    __device__ __forceinline__ void operator()(const AccT& acc, const Unit& u, int wr, int wc, int fr, int fq, int lane) const {
        const int row0 = u.pm * 256 + wr * 64 + fr, col0 = u.pn * 256 + wc * 32 + 4 * fq;
#pragma unroll
        for (int ai = 0; ai < 2; ++ai)
#pragma unroll
            for (int m = 0; m < 4; ++m) {
                const int row = row0 + ai * 128 + m * 16; const bool real = row < MREAL;
                const float* xr = row < MPR ? xp + (size_t)row * D : xs + (size_t)(row - MPR) * D;
                float ss = 0.f;
#pragma unroll
                for (int bj = 0; bj < 2; ++bj)
#pragma unroll
                    for (int n = 0; n < 2; ++n) {
                        const int col = col0 + bj * 128 + n * 16;
                        f32x4 v = acc[ai][bj][m][n];
                        if (real) { v += *(const f32x4*)(xr + col); *(f32x4*)(out + (size_t)row * D + col) = v; }
                        ss += (v[0] * v[0] + v[1] * v[1]) + (v[2] * v[2] + v[3] * v[3]);
                        u32x2 w; w.x = cvt_pk_bf16(v[0], v[1]); w.y = cvt_pk_bf16(v[2], v[3]);
                        *(u32x2*)(XN + (size_t)row * D + col) = w;
                    }
                ss += __shfl_xor(ss, 16); ss += __shfl_xor(ss, 32);
                if (fq == 0) rsp[(size_t)row * 16 + u.pn * 4 + wc] = ss;
            }
    }
};
struct Epi5 {
    static constexpr bool PERM = true;
    bf16_t* H; const float* rsp;
    __device__ __forceinline__ void operator()(const AccT& acc, const Unit& u, int wr, int wc, int fr, int fq, int lane) const {
        float rs[2][4]; fetch_rowscale(rsp, u.pm, wr, lane, fr, rs);
        const int row0 = u.pm * 256 + wr * 64 + fr, col = u.pn * 128 + wc * 32 + 8 * fq;
#pragma unroll
        for (int ai = 0; ai < 2; ++ai)
#pragma unroll
            for (int m = 0; m < 4; ++m) {
                const float r = rs[ai][m];
                const f32x4 g0 = acc[ai][0][m][0] * r, g1 = acc[ai][0][m][1] * r, u0 = acc[ai][1][m][0] * r, u1 = acc[ai][1][m][1] * r;
                u32x4 w;
                w.x = cvt_pk_bf16(g0[0] * fast_sigmoid(g0[0]) * u0[0], g0[1] * fast_sigmoid(g0[1]) * u0[1]);
                w.y = cvt_pk_bf16(g0[2] * fast_sigmoid(g0[2]) * u0[2], g0[3] * fast_sigmoid(g0[3]) * u0[3]);
                w.z = cvt_pk_bf16(g1[0] * fast_sigmoid(g1[0]) * u1[0], g1[1] * fast_sigmoid(g1[1]) * u1[1]);
                w.w = cvt_pk_bf16(g1[2] * fast_sigmoid(g1[2]) * u1[2], g1[3] * fast_sigmoid(g1[3]) * u1[3]);
                *(u32x4*)(H + (size_t)(row0 + ai * 128 + m * 16) * DFF + col) = w;
            }
    }
};
struct Epi6 {
    static constexpr bool PERM = false;
    float* out; float* rsp;
    __device__ __forceinline__ void operator()(const AccT& acc, const Unit& u, int wr, int wc, int fr, int fq, int lane) const {
        const int row0 = u.pm * 256 + wr * 64 + fr, col0 = u.pn * 256 + wc * 32 + 4 * fq;
#pragma unroll
        for (int ai = 0; ai < 2; ++ai)
#pragma unroll
            for (int m = 0; m < 4; ++m) {
                const int row = row0 + ai * 128 + m * 16; const bool real = row < MREAL;
                float ss = 0.f;
                if (real) {
#pragma unroll
                    for (int bj = 0; bj < 2; ++bj)
#pragma unroll
                        for (int n = 0; n < 2; ++n) {
                            float* p = out + (size_t)row * D + col0 + bj * 128 + n * 16;
                            const f32x4 v = *(const f32x4*)p + acc[ai][bj][m][n];
                            *(f32x4*)p = v;
                            ss += (v[0] * v[0] + v[1] * v[1]) + (v[2] * v[2] + v[3] * v[3]);
                        }
                }
                ss += __shfl_xor(ss, 16); ss += __shfl_xor(ss, 32);
                if (fq == 0) rsp[(size_t)row * 16 + u.pn * 4 + wc] = ss;
            }
    }
};

template <int NTL, int K, class F>
__device__ __forceinline__ void side_unit(const bf16_t* A128, const bf16_t* B0, const bf16_t* B1, const F& f, int wid, int lane) {
    const int l15 = lane & 15, gq = lane >> 4;
    const bf16_t* ap = A128 + (size_t)(16 * wid + l15) * K + 8 * gq;
    const bf16_t* bp0 = B0 + (size_t)l15 * K + 8 * gq;
    const bf16_t* bp1 = B1 + (size_t)l15 * K + 8 * gq;
    f32x4 acc0 = (f32x4){0.f, 0.f, 0.f, 0.f}, acc1 = (f32x4){0.f, 0.f, 0.f, 0.f};
    constexpr int NKS = K / 32, KB = (NTL == 1) ? 16 : 8;
#pragma unroll
    for (int ks0 = 0; ks0 < NKS; ks0 += KB) {
        bf16x8 a[KB], b0[KB], b1[KB];
#pragma unroll
        for (int i = 0; i < KB; ++i) if (ks0 + i < NKS) {
            a[i] = *(const bf16x8*)(ap + 32 * (ks0 + i)); b0[i] = *(const bf16x8*)(bp0 + 32 * (ks0 + i));
            if (NTL == 2) b1[i] = *(const bf16x8*)(bp1 + 32 * (ks0 + i));
        }
        __builtin_amdgcn_sched_barrier(0);
#pragma unroll
        for (int i = 0; i < KB; ++i) if (ks0 + i < NKS) {
            acc0 = __builtin_amdgcn_mfma_f32_16x16x32_bf16(b0[i], a[i], acc0, 0, 0, 0);
            if (NTL == 2) acc1 = __builtin_amdgcn_mfma_f32_16x16x32_bf16(b1[i], a[i], acc1, 0, 0, 0);
        }
        __builtin_amdgcn_sched_barrier(0);
    }
    f(acc0, acc1, 16 * wid + l15, 4 * gq, gq);
}
__device__ __forceinline__ float quad_sum(float v) { v += __shfl_xor(v, 16); v += __shfl_xor(v, 32); return v; }
__device__ __forceinline__ float sum64(const float* p) {
    float s = 0.f;
#pragma unroll
    for (int j = 0; j < 16; ++j) { const f32x4 v = ((const f32x4*)p)[j]; s += (v[0] + v[1]) + (v[2] + v[3]); }
    return s;
}
struct Side1 {
    bf16_t *U, *GV, *SB, *SGA, *SGB; const float* rstd; float* vsts; int n0;
    __device__ __forceinline__ void one(const f32x4& acc, int r, int col, int gq) const {
        const int row = MPR + r; const float rs = rstd[row];
        f32x4 v = acc * rs;
        if (col < 2048) {
#pragma unroll
            for (int j = 0; j < 4; ++j) v[j] = gelu_tanh(v[j]);
            if (col >= 1024) {
                const float s1 = quad_sum((v[0] + v[1]) + (v[2] + v[3])), s2 = quad_sum((v[0] * v[0] + v[1] * v[1]) + (v[2] * v[2] + v[3] * v[3]));
                if (gq == 0) *(f32x2*)(vsts + ((size_t)r * 64 + ((col - 1024) >> 4)) * 2) = (f32x2){s1, s2};
            }
        } else if (col >= 2560) {
#pragma unroll
            for (int j = 0; j < 4; ++j) v[j] = fast_sigmoid(v[j]);
        }
        u32x2 w; w.x = cvt_pk_bf16(v[0], v[1]); w.y = cvt_pk_bf16(v[2], v[3]);
        if (col < 1024) *(u32x2*)(U + (size_t)row * D + col) = w;
        else if (col < 2048) *(u32x2*)(GV + (size_t)row * D + col - 1024) = w;
        else if (col < 2560) { const int cs = col - 2048; *(u32x2*)(SB + ((size_t)(cs >> 4) * MP + row) * 16 + (cs & 15)) = w; }
        else if (col < 3584) *(u32x2*)(SGA + (size_t)row * D + col - 2560) = w;
        else *(u32x2*)(SGB + (size_t)row * D + col - 3584) = w;
    }
    __device__ __forceinline__ void operator()(const f32x4& a0, const f32x4& a1, int r, int c4, int gq) const { one(a0, r, n0 + c4, gq); one(a1, r, n0 + 16 + c4, gq); }
};
struct Side3a {
    bf16_t* T2; const bf16_t* SGB; int c0;
    __device__ __forceinline__ void operator()(const f32x4& a0, const f32x4& a1, int r, int c4, int gq) const {
        const size_t off = (size_t)(MPR + r) * D + c0 + c4; const u32x2 sg = *(const u32x2*)(SGB + off);
        u32x2 w; w.x = cvt_pk_bf16(bf_lo(sg.x) * a0[0] * fast_sigmoid(a1[0]), bf_hi(sg.x) * a0[1] * fast_sigmoid(a1[1]));
        w.y = cvt_pk_bf16(bf_lo(sg.y) * a0[2] * fast_sigmoid(a1[2]), bf_hi(sg.y) * a0[3] * fast_sigmoid(a1[3]));
        *(u32x2*)(T2 + off) = w;
    }
};
struct Side3b {
    bf16_t* MG; const bf16_t* SGA; const bf16_t* T2; int c0;
    __device__ __forceinline__ void operator()(const f32x4& a0, const f32x4&, int r, int c4, int gq) const {
        const size_t off = (size_t)(MPR + r) * D + c0 + c4; const u32x2 sg = *(const u32x2*)(SGA + off), t2 = *(const u32x2*)(T2 + off);
        u32x2 w; w.x = cvt_pk_bf16(bf_lo(sg.x) * a0[0] + bf_lo(t2.x), bf_hi(sg.x) * a0[1] + bf_hi(t2.x));
        w.y = cvt_pk_bf16(bf_lo(sg.y) * a0[2] + bf_lo(t2.y), bf_hi(sg.y) * a0[3] + bf_hi(t2.y));
        *(u32x2*)(MG + off) = w;
    }
};
struct Side4 {
    const float* xs; float* out; bf16_t* XN; float* rs2s; int c0;
    __device__ __forceinline__ void operator()(const f32x4& a0, const f32x4&, int r, int c4, int gq) const {
        const f32x4 v = a0 + *(const f32x4*)(xs + (size_t)r * D + c0 + c4);
        *(f32x4*)(out + (size_t)(MPR + r) * D + c0 + c4) = v;
        u32x2 w; w.x = cvt_pk_bf16(v[0], v[1]); w.y = cvt_pk_bf16(v[2], v[3]);
        *(u32x2*)(XN + (size_t)(MPR + r) * D + c0 + c4) = w;
        const float ss = quad_sum((v[0] * v[0] + v[1] * v[1]) + (v[2] * v[2] + v[3] * v[3]));
        if (gq == 0) rs2s[r * 64 + (c0 >> 4)] = ss;
    }
};
struct Side5 {
    bf16_t* H; const float* rs2s; int c0;
    __device__ __forceinline__ void operator()(const f32x4& a0, const f32x4& a1, int r, int c4, int gq) const {
        const float rr = __builtin_amdgcn_rsqf(sum64(rs2s + r * 64) * (1.0f / D) + EPS);
        const f32x4 g = a0 * rr, u = a1 * rr;
        u32x2 w; w.x = cvt_pk_bf16(g[0] * fast_sigmoid(g[0]) * u[0], g[1] * fast_sigmoid(g[1]) * u[1]);
        w.y = cvt_pk_bf16(g[2] * fast_sigmoid(g[2]) * u[2], g[3] * fast_sigmoid(g[3]) * u[3]);
        *(u32x2*)(H + (size_t)(MPR + r) * DFF + c0 + c4) = w;
    }
};
struct Side6 {
    float* out; float* rs3s; int c0;
    __device__ __forceinline__ void operator()(const f32x4& a0, const f32x4&, int r, int c4, int gq) const {
        float* p = out + (size_t)(MPR + r) * D + c0 + c4;
        const f32x4 v = *(const f32x4*)p + a0; *(f32x4*)p = v;
        const float ss = quad_sum((v[0] * v[0] + v[1] * v[1]) + (v[2] * v[2] + v[3] * v[3]));
        if (gq == 0) rs3s[r * 64 + (c0 >> 4)] = ss;
    }
};

__device__ __forceinline__ void cpow_lam(float lre, float lim, float dt, int n, float& mr, float& mi) {
    const float mag = expf((float)n * dt * lre);
    double a = (double)n * (double)dt * (double)lim;
    const double k = rint(a * 0.15915494309189535);
    a = fma(-k, 6.283185307179586, a);
    const double r2 = a * a;
    double s = 1.0 - r2 * (1.0 / 420.0);
    s = 1.0 - r2 * (1.0 / 342.0) * s; s = 1.0 - r2 * (1.0 / 272.0) * s; s = 1.0 - r2 * (1.0 / 210.0) * s; s = 1.0 - r2 * (1.0 / 156.0) * s;
    s = 1.0 - r2 * (1.0 / 110.0) * s; s = 1.0 - r2 * (1.0 / 72.0) * s; s = 1.0 - r2 * (1.0 / 42.0) * s; s = 1.0 - r2 * (1.0 / 20.0) * s; s = 1.0 - r2 * (1.0 / 6.0) * s;
    s *= a;
    double c = 1.0 - r2 * (1.0 / 462.0);
    c = 1.0 - r2 * (1.0 / 380.0) * c; c = 1.0 - r2 * (1.0 / 306.0) * c; c = 1.0 - r2 * (1.0 / 240.0) * c; c = 1.0 - r2 * (1.0 / 182.0) * c; c = 1.0 - r2 * (1.0 / 132.0) * c;
    c = 1.0 - r2 * (1.0 / 90.0) * c; c = 1.0 - r2 * (1.0 / 56.0) * c; c = 1.0 - r2 * (1.0 / 30.0) * c; c = 1.0 - r2 * (1.0 / 12.0) * c; c = 1.0 - r2 * (1.0 / 2.0) * c;
    mr = mag * (float)c; mi = mag * (float)s;
}
__device__ __forceinline__ void zoh_coef(float lre, float lim, float dt, float& cr, float& ci) {
    float br, bi; cpow_lam(lre, lim, dt, 1, br, bi);
    const float nr = br - 1.0f, ni = bi, den = 1.0f / (lre * lre + lim * lim);
    cr = (nr * lre + ni * lim) * den; ci = (ni * lre - nr * lim) * den;
}

struct Args { const float* in[26]; float* out; unsigned char* ws; int ph_lo, ph_hi; };
enum { I_XP = 0, I_XS, I_SRE, I_SIM, I_G1, I_WIN, I_LVG, I_LVB, I_WSP, I_BSP, I_LRE, I_LIM, I_LDT, I_BRE, I_BIM, I_CRE, I_CIM, I_SD, I_WA, I_WB, I_WO, I_G2, I_WG, I_WU, I_WD, I_GF };

__device__ __forceinline__ void p0_transpose_item(const float* W, int Nsrc, int Kdst, const float* gain, bf16_t* WT, int k0, int n0, int drow0, LAS float* scr, int lane) {
    {
        const int kr = lane >> 3, c4 = lane & 7;
        f32x4 v[8];
#pragma unroll
        for (int i = 0; i < 8; ++i) v[i] = *(const f32x4*)(W + (size_t)(k0 + 8 * i + kr) * Nsrc + n0 + 4 * c4);
        if (gain) {
#pragma unroll
            for (int i = 0; i < 8; ++i) v[i] *= gain[k0 + 8 * i + kr];
        }
#pragma unroll
        for (int i = 0; i < 8; ++i) { LAS float* d = scr + (8 * i + kr) * 33 + 4 * c4; d[0] = v[i][0]; d[1] = v[i][1]; d[2] = v[i][2]; d[3] = v[i][3]; }
    }
    asm volatile("s_waitcnt lgkmcnt(0)" ::: "memory");
    const int c = lane & 7;
#pragma unroll
    for (int j = 0; j < 4; ++j) { const int n = (lane >> 3) + 8 * j; const LAS float* s = scr + (8 * c) * 33 + n;
        u32x4 o; o.x = cvt_pk_bf16(s[0 * 33], s[1 * 33]); o.y = cvt_pk_bf16(s[2 * 33], s[3 * 33]); o.z = cvt_pk_bf16(s[4 * 33], s[5 * 33]); o.w = cvt_pk_bf16(s[6 * 33], s[7 * 33]);
        *(u32x4*)(WT + (size_t)(drow0 + n) * Kdst + k0 + 8 * c) = o; }
    asm volatile("s_waitcnt lgkmcnt(0)" ::: "memory");
}
__device__ __forceinline__ void p0_prologue(const Args& args, LAS unsigned char* L, int vcu, int G, int tid, int wave, int lane) {
    unsigned char* ws = args.ws;
    LAS float* scr = (LAS float*)(L + wave * 16384);
    const int gw = vcu * NWAVES + wave, NGW = G * NWAVES;
    constexpr int I_IN = 16 * 144, I_A = 16 * 32, I_B = 8 * 64, I_O = 16 * 32, I_G = 16 * 88, I_U = 16 * 88, I_D = 44 * 32;
    constexpr int NITEMS = I_IN + I_A + I_B + I_O + I_G + I_U + I_D;
    for (int it = gw; it < NITEMS; it += NGW) {
        int r = it;
        if (r < I_IN) { const int kb = r / 144, nb = r % 144; p0_transpose_item(args.in[I_WIN], NIN, D, args.in[I_G1], (bf16_t*)(ws + WS_WIN), 64 * kb, 32 * nb, 32 * nb, scr, lane); continue; } r -= I_IN;
        if (r < I_A) { const int kb = r / 32, nb = r % 32; p0_transpose_item(args.in[I_WA], D, D, nullptr, (bf16_t*)(ws + WS_WA), 64 * kb, 32 * nb, 32 * nb, scr, lane); continue; } r -= I_A;
        if (r < I_B) { const int kb = r / 64, nb = r % 64; const int n0 = 32 * nb, half = n0 >> 10, c = n0 & 1023;
            p0_transpose_item(args.in[I_WB], 2 * D, SW, nullptr, (bf16_t*)(ws + WS_WB), 64 * kb, n0, (c >> 7) * 256 + half * 128 + (c & 127), scr, lane); continue; } r -= I_B;
        if (r < I_O) { const int kb = r / 32, nb = r % 32; p0_transpose_item(args.in[I_WO], D, D, nullptr, (bf16_t*)(ws + WS_WO), 64 * kb, 32 * nb, 32 * nb, scr, lane); continue; } r -= I_O;
        if (r < I_G) { const int kb = r / 88, nb = r % 88; const int c = 32 * nb;
            p0_transpose_item(args.in[I_WG], DFF, D, args.in[I_G2], (bf16_t*)(ws + WS_WGU), 64 * kb, c, (c >> 7) * 256 + (c & 127), scr, lane); continue; } r -= I_G;
        if (r < I_U) { const int kb = r / 88, nb = r % 88; const int c = 32 * nb;
            p0_transpose_item(args.in[I_WU], DFF, D, args.in[I_G2], (bf16_t*)(ws + WS_WGU), 64 * kb, c, (c >> 7) * 256 + 128 + (c & 127), scr, lane); continue; } r -= I_U;
        { const int kb = r / 32, nb = r % 32; p0_transpose_item(args.in[I_WD], D, DFF, nullptr, (bf16_t*)(ws + WS_WD), 64 * kb, 32 * nb, 32 * nb, scr, lane); }
    }
    bf16_t* XB = (bf16_t*)(ws + WS_XB); float* rstd1 = (float*)(ws + WS_RSTD1);
    for (int m0 = 4 * gw; m0 < MREAL; m0 += 4 * NGW) {
        f32x4 v[4][4];
#pragma unroll
        for (int r = 0; r < 4; ++r) { const int m = m0 + r; const float* xr = m < MPR ? args.in[I_XP] + (size_t)m * D : args.in[I_XS] + (size_t)(m - MPR) * D;
#pragma unroll
            for (int j = 0; j < 4; ++j) v[r][j] = ((const f32x4*)xr + lane)[64 * j]; }
#pragma unroll
        for (int r = 0; r < 4; ++r) { const int m = m0 + r; float s = 0.f;
#pragma unroll
            for (int j = 0; j < 4; ++j) s += (v[r][j][0] * v[r][j][0] + v[r][j][1] * v[r][j][1]) + (v[r][j][2] * v[r][j][2] + v[r][j][3] * v[r][j][3]);
            s = wave_sum(s);
            u32x2* o8 = (u32x2*)(XB + (size_t)m * D) + lane;
#pragma unroll
            for (int j = 0; j < 4; ++j) o8[64 * j] = (u32x2){cvt_pk_bf16(v[r][j][0], v[r][j][1]), cvt_pk_bf16(v[r][j][2], v[r][j][3])};
            if (lane == 0) rstd1[m] = 1.0f / sqrtf(s * (1.0f / D) + EPS); }
    }
    const int gt = vcu * NTHR + tid, NT = G * NTHR;
    { bf16_t* WSPb = (bf16_t*)(ws + WS_WSP); const float* wsp = args.in[I_WSP];
      for (int i = gt; i < 8 * 128 * 128; i += NT) { const int t = (i >> 7) & 127, s = i & 127; const float v = s <= t ? wsp[i] : 0.f; WSPb[i] = (bf16_t)(cvt_pk_bf16(v, 0.f) & 0xffffu); } }
    const float *lre_ = args.in[I_LRE], *lim_ = args.in[I_LIM], *ldt_ = args.in[I_LDT], *bre_ = args.in[I_BRE], *bim_ = args.in[I_BIM], *cre_ = args.in[I_CRE], *cim_ = args.in[I_CIM], *sd_ = args.in[I_SD];
    { bf16_t* KK = (bf16_t*)(ws + WS_KK);
      for (int i = gt; i < SG * TC * SH * 8; i += NT) {
          const int sub = i & 7, item = i >> 3, h = item & 15, d = (item >> 4) & 31, g = item >> 9;
          const float dt = expf(ldt_[g]);
          float acc[16];
#pragma unroll
          for (int j = 0; j < 16; ++j) acc[j] = 0.f;
          for (int pp = 0; pp < 8; ++pp) {
              const int p = sub * 8 + pp; const float lr = lre_[g * 64 + p], li = lim_[g * 64 + p];
              float pr, pi; cpow_lam(lr, li, dt, d, pr, pi);
              float cr, ci; zoh_coef(lr, li, dt, cr, ci);
              const float c_r = cre_[(g * 16 + h) * 64 + p], c_i = cim_[(g * 16 + h) * 64 + p];
              const float t_r = c_r * pr - c_i * pi, t_i = c_r * pi + c_i * pr;
              const float z_r = t_r * cr - t_i * ci, z_i = t_r * ci + t_i * cr;
#pragma unroll
              for (int j = 0; j < 16; ++j) acc[j] += z_r * bre_[(g * 64 + p) * 16 + j] - z_i * bim_[(g * 64 + p) * 16 + j];
          }
#pragma unroll
          for (int j = 0; j < 16; ++j) { float v = acc[j]; v += __shfl_xor(v, 1); v += __shfl_xor(v, 2); v += __shfl_xor(v, 4); acc[j] = v; }
          if (sub == 0) {
              if (d == 0) {
#pragma unroll
                  for (int j = 0; j < 16; ++j) if (j == h) acc[j] += sd_[g * 16 + h];
              }
              u32x4 w0, w1;
              w0.x = cvt_pk_bf16(acc[0], acc[1]); w0.y = cvt_pk_bf16(acc[2], acc[3]); w0.z = cvt_pk_bf16(acc[4], acc[5]); w0.w = cvt_pk_bf16(acc[6], acc[7]);
              w1.x = cvt_pk_bf16(acc[8], acc[9]); w1.y = cvt_pk_bf16(acc[10], acc[11]); w1.z = cvt_pk_bf16(acc[12], acc[13]); w1.w = cvt_pk_bf16(acc[14], acc[15]);
              bf16_t* dst = KK + ((size_t)(g * 32 + d) * 16 + h) * 32;
              *(u32x4*)dst = w0; *(u32x4*)(dst + 8) = w1;
              if (d < 31) { bf16_t* dn = KK + ((size_t)(g * 32 + d + 1) * 16 + h) * 32 + 16; *(u32x4*)dn = w0; *(u32x4*)(dn + 8) = w1; }
              if (d == 0) { *(u32x4*)(dst + 16) = (u32x4){0u, 0u, 0u, 0u}; *(u32x4*)(dst + 24) = (u32x4){0u, 0u, 0u, 0u}; }
          }
      } }
    { bf16_t* CC = (bf16_t*)(ws + WS_CCAR);
      for (int i = gt; i < SG * TC * SP; i += NT) {
          const int p = i & 63, t = (i >> 6) & 31, g = i >> 11;
          const float dt = expf(ldt_[g]); float pr, pi; cpow_lam(lre_[g * 64 + p], lim_[g * 64 + p], dt, t + 1, pr, pi);
          for (int h = 0; h < 16; ++h) { const float c_r = cre_[(g * 16 + h) * 64 + p], c_i = cim_[(g * 16 + h) * 64 + p];
              bf16_t* dst = CC + ((size_t)(g * 512 + 16 * t + h)) * 128;
              dst[p] = (bf16_t)(cvt_pk_bf16(c_r * pr - c_i * pi, 0.f) & 0xffffu); dst[64 + p] = (bf16_t)(cvt_pk_bf16(-(c_r * pi + c_i * pr), 0.f) & 0xffffu); }
      } }
    { bf16_t* BS = (bf16_t*)(ws + WS_BST);
      for (int i = gt; i < SG * SP * TC; i += NT) {
          const int s = i & 31, p = (i >> 5) & 63, g = i >> 11;
          const float dt = expf(ldt_[g]); const float lr = lre_[g * 64 + p], li = lim_[g * 64 + p];
          float pr, pi; cpow_lam(lr, li, dt, 31 - s, pr, pi); float cr, ci; zoh_coef(lr, li, dt, cr, ci);
          const float z_r = pr * cr - pi * ci, z_i = pr * ci + pi * cr;
          float vr[16], vi[16];
#pragma unroll
          for (int j = 0; j < 16; ++j) { const float b_r = bre_[(g * 64 + p) * 16 + j], b_i = bim_[(g * 64 + p) * 16 + j]; vr[j] = z_r * b_r - z_i * b_i; vi[j] = z_r * b_i + z_i * b_r; }
          bf16_t* d0 = BS + ((size_t)(g * 128 + p)) * 512 + s * 16; bf16_t* d1 = BS + ((size_t)(g * 128 + 64 + p)) * 512 + s * 16;
          u32x4 w;
          w.x = cvt_pk_bf16(vr[0], vr[1]); w.y = cvt_pk_bf16(vr[2], vr[3]); w.z = cvt_pk_bf16(vr[4], vr[5]); w.w = cvt_pk_bf16(vr[6], vr[7]); *(u32x4*)d0 = w;
          w.x = cvt_pk_bf16(vr[8], vr[9]); w.y = cvt_pk_bf16(vr[10], vr[11]); w.z = cvt_pk_bf16(vr[12], vr[13]); w.w = cvt_pk_bf16(vr[14], vr[15]); *(u32x4*)(d0 + 8) = w;
          w.x = cvt_pk_bf16(vi[0], vi[1]); w.y = cvt_pk_bf16(vi[2], vi[3]); w.z = cvt_pk_bf16(vi[4], vi[5]); w.w = cvt_pk_bf16(vi[6], vi[7]); *(u32x4*)d1 = w;
          w.x = cvt_pk_bf16(vi[8], vi[9]); w.y = cvt_pk_bf16(vi[10], vi[11]); w.z = cvt_pk_bf16(vi[12], vi[13]); w.w = cvt_pk_bf16(vi[14], vi[15]); *(u32x4*)(d1 + 8) = w;
      } }
    { float* LT = (float*)(ws + WS_LAMT);
      for (int i = gt; i < SG * SP; i += NT) { const int g = i >> 6; float pr, pi; cpow_lam(lre_[i], lim_[i], expf(ldt_[g]), TC, pr, pi); LT[2 * i] = pr; LT[2 * i + 1] = pi; } }
}

__device__ __forceinline__ unsigned off_b(unsigned row, unsigned ch) { return 256u * row + 16u * (ch ^ (((row & 3) << 2) | ((row >> 2) & 3))); }
__device__ __forceinline__ s16x4 tr_read(unsigned lds_addr) { s16x4 r; asm volatile("ds_read_b64_tr_b16 %0, %1\n\ts_waitcnt lgkmcnt(0)" : "=&v"(r) : "v"(lds_addr) : "memory"); return r; }

__device__ __forceinline__ void spatial_unit(const Args& args, LAS unsigned char* L, int b, int n, int g, int tid, int wid, int lane) {
    unsigned char* ws = args.ws;
    constexpr int VOFF = 0, WOFF = 32768, OOFF = 65536, SOFF = 100352;
    const int tok0 = b * SEQ + n * 128;
    const bf16_t* GV = (const bf16_t*)(ws + WS_GV); const bf16_t* Ub = (const bf16_t*)(ws + WS_U); bf16_t* Gb = (bf16_t*)(ws + WS_XB);
    const float* vstat = (const float*)(ws + WS_VSTAT); const bf16_t* WSPb = (const bf16_t*)(ws + WS_WSP) + (size_t)g * 16384;
    if (tid < 128) {
        const f32x4* p = (const f32x4*)(vstat + (size_t)(tok0 + tid) * 32);
        float s1 = 0.f, s2 = 0.f;
#pragma unroll
        for (int j = 0; j < 8; ++j) { const f32x4 v = p[j]; s1 += v[0] + v[2]; s2 += v[1] + v[3]; }
        const float mean = s1 * (1.0f / D), var = s2 * (1.0f / D) - mean * mean;
        *(LAS f32x2*)(L + SOFF + tid * 8) = (f32x2){mean, 1.0f / sqrtf(var + EPS)};
    }
    __syncthreads();
    const float* lvg = args.in[I_LVG] + g * 128; const float* lvb = args.in[I_LVB] + g * 128;
#pragma unroll
    for (int i = 0; i < 4; ++i) {
        const int q = tid + 512 * i, s = q >> 4, ch = q & 15;
        const u32x4 raw = *(const u32x4*)(GV + (size_t)(tok0 + s) * D + g * 128 + ch * 8);
        const f32x2 st = *(const LAS f32x2*)(L + SOFF + s * 8);
        const f32x4 g0 = *(const f32x4*)(lvg + ch * 8), g1 = *(const f32x4*)(lvg + ch * 8 + 4), b0 = *(const f32x4*)(lvb + ch * 8), b1 = *(const f32x4*)(lvb + ch * 8 + 4);
        u32x4 w;
        w.x = cvt_pk_bf16((bf_lo(raw.x) - st.x) * st.y * g0[0] + b0[0], (bf_hi(raw.x) - st.x) * st.y * g0[1] + b0[1]);
        w.y = cvt_pk_bf16((bf_lo(raw.y) - st.x) * st.y * g0[2] + b0[2], (bf_hi(raw.y) - st.x) * st.y * g0[3] + b0[3]);
        w.z = cvt_pk_bf16((bf_lo(raw.z) - st.x) * st.y * g1[0] + b1[0], (bf_hi(raw.z) - st.x) * st.y * g1[1] + b1[1]);
        w.w = cvt_pk_bf16((bf_lo(raw.w) - st.x) * st.y * g1[2] + b1[2], (bf_hi(raw.w) - st.x) * st.y * g1[3] + b1[3]);
        *(LAS u32x4*)(L + VOFF + off_b(s, ch)) = w;
        *(LAS u32x4*)(L + WOFF + off_b(s, ch)) = *(const u32x4*)(WSPb + (size_t)s * 128 + ch * 8);
    }
    __syncthreads();
    {
        const int cb = wid, gq = lane >> 4, q4 = (lane & 15) >> 2, p4 = lane & 3;
        const unsigned lbase = (unsigned)(size_t)(L + VOFF);
        bf16x8 vf[4];
#pragma unroll
        for (int ks = 0; ks < 4; ++ks) {
            const s16x4 lo = tr_read(lbase + off_b(32 * ks + 8 * gq + q4, 2 * cb + (p4 >> 1)) + 8 * (p4 & 1));
            const s16x4 hi = tr_read(lbase + off_b(32 * ks + 8 * gq + 4 + q4, 2 * cb + (p4 >> 1)) + 8 * (p4 & 1));
            vf[ks] = (bf16x8){lo[0], lo[1], lo[2], lo[3], hi[0], hi[1], hi[2], hi[3]};
        }
#pragma unroll
        for (int rb = 0; rb < 8; ++rb) {
            f32x4 acc = (f32x4){0.f, 0.f, 0.f, 0.f};
#pragma unroll
            for (int ks = 0; ks <= (rb >> 1); ++ks) {
                const bf16x8 wf = *(const LAS bf16x8*)(L + WOFF + off_b((lane & 15) + 16 * rb, 4 * ks + gq));
                acc = __builtin_amdgcn_mfma_f32_16x16x32_bf16(vf[ks], wf, acc, 0, 0, 0);
            }
            u32x2 w; w.x = cvt_pk_bf16(acc[0], acc[1]); w.y = cvt_pk_bf16(acc[2], acc[3]);
            *(LAS u32x2*)(L + OOFF + (16 * rb + (lane & 15)) * 272 + (16 * cb + 4 * gq) * 2) = w;
        }
    }
    __syncthreads();
    const float* bsp = args.in[I_BSP] + g * 128;
#pragma unroll
    for (int i = 0; i < 4; ++i) {
        const int q = tid + 512 * i, t = q >> 4, ch = q & 15;
        const u32x4 mx = *(const LAS u32x4*)(L + OOFF + t * 272 + ch * 16);
        const size_t off = (size_t)(tok0 + t) * D + g * 128 + ch * 8;
        const u32x4 uu = *(const u32x4*)(Ub + off);
        const float bb = bsp[t];
        u32x4 w;
        w.x = cvt_pk_bf16(bf_lo(uu.x) * (bf_lo(mx.x) + bb), bf_hi(uu.x) * (bf_hi(mx.x) + bb));
        w.y = cvt_pk_bf16(bf_lo(uu.y) * (bf_lo(mx.y) + bb), bf_hi(uu.y) * (bf_hi(mx.y) + bb));
        w.z = cvt_pk_bf16(bf_lo(uu.z) * (bf_lo(mx.z) + bb), bf_hi(uu.z) * (bf_hi(mx.z) + bb));
        w.w = cvt_pk_bf16(bf_lo(uu.w) * (bf_lo(mx.w) + bb), bf_hi(uu.w) * (bf_hi(mx.w) + bb));
        *(u32x4*)(Gb + off) = w;
    }
    __syncthreads();
}

__device__ __forceinline__ void ssm_unit(const Args& args, LAS unsigned char* L, int b, int g, int tid, int wid, int lane) {
    unsigned char* ws = args.ws;
    constexpr int UOFF = 0, USTR = 1040, SOFF = 66560, SSTR = 528, HOFF = 100352, HSTR = 272, KOFF = 117760;
    const bf16_t* ub = (const bf16_t*)(ws + WS_SB) + ((size_t)g * MP + (size_t)b * SEQ) * 16;
#pragma unroll
    for (int i = 0; i < 8; ++i) { const int q = tid + 512 * i, tok = q >> 1, half = q & 1;
        *(LAS u32x4*)(L + UOFF + (tok >> 5) * USTR + (tok & 31) * 32 + half * 16) = *(const u32x4*)(ub + (size_t)q * 8); }
    const bf16_t* kk = (const bf16_t*)(ws + WS_KK) + (size_t)g * 16384;
#pragma unroll
    for (int i = 0; i < 4; ++i) { const int q = tid + 512 * i; *(LAS u32x4*)(L + KOFF + q * 16) = *(const u32x4*)(kk + (size_t)q * 8); }
    __syncthreads();
    const int l15 = lane & 15, gq = lane >> 4;
    {
        const int rb = wid;
        f32x4 acc[4];
#pragma unroll
        for (int cb = 0; cb < 4; ++cb) acc[cb] = (f32x4){0.f, 0.f, 0.f, 0.f};
        const bf16_t* ap = (const bf16_t*)(ws + WS_BST) + ((size_t)(g * 128 + 16 * rb + l15)) * 512 + 8 * gq;
#pragma unroll 4
        for (int ks = 0; ks < 16; ++ks) {
            const bf16x8 a = *(const bf16x8*)(ap + 32 * ks);
#pragma unroll
            for (int cb = 0; cb < 4; ++cb) {
                const bf16x8 bf = *(const LAS bf16x8*)(L + UOFF + (16 * cb + l15) * USTR + (2 * ks + (gq >> 1)) * 32 + (gq & 1) * 16);
                acc[cb] = __builtin_amdgcn_mfma_f32_16x16x32_bf16(a, bf, acc[cb], 0, 0, 0);
            }
        }
#pragma unroll
        for (int cb = 0; cb < 4; ++cb) *(LAS f32x4*)(L + SOFF + (16 * cb + l15) * SSTR + (16 * rb + 4 * gq) * 4) = acc[cb];
    }
    __syncthreads();
    if (wid == 0) {
        const float* lt = (const float*)(ws + WS_LAMT) + (size_t)(g * 64 + lane) * 2;
        const float lr = lt[0], li = lt[1];
        float hr = 0.f, hi = 0.f;
#pragma unroll 8
        for (int n = 0; n < NCH; ++n) {
            *(LAS bf16_t*)(L + HOFF + n * HSTR + lane * 2) = (bf16_t)(cvt_pk_bf16(hr, 0.f) & 0xffffu);
            *(LAS bf16_t*)(L + HOFF + n * HSTR + (64 + lane) * 2) = (bf16_t)(cvt_pk_bf16(hi, 0.f) & 0xffffu);
            const float sr = *(const LAS float*)(L + SOFF + n * SSTR + lane * 4), si = *(const LAS float*)(L + SOFF + n * SSTR + (64 + lane) * 4);
            const float nr = lr * hr - li * hi + sr, ni = lr * hi + li * hr + si;
            hr = nr; hi = ni;
        }
        args.out[O_PRE + (size_t)(b * SG + g) * SP + lane] = hr;
        args.out[O_PIM + (size_t)(b * SG + g) * SP + lane] = hi;
    }
    f32x4 acc[4][4];
#pragma unroll
    for (int ti = 0; ti < 4; ++ti)
#pragma unroll
        for (int cb = 0; cb < 4; ++cb) acc[ti][cb] = (f32x4){0.f, 0.f, 0.f, 0.f};
#pragma unroll 2
    for (int s0 = 0; s0 < TC; s0 += 2) {
        bf16x8 bf[4];
#pragma unroll
        for (int cb = 0; cb < 4; ++cb) bf[cb] = *(const LAS bf16x8*)(L + UOFF + (16 * cb + l15) * USTR + (s0 + (gq >> 1)) * 32 + (gq & 1) * 16);
#pragma unroll
        for (int ti = 0; ti < 4; ++ti) {
            const int t = wid + 8 * ti;
            if (t >= s0) {
                const bf16x8 a = *(const LAS bf16x8*)(L + KOFF + (t - s0) * 1024 + l15 * 64 + gq * 16);
#pragma unroll
                for (int cb = 0; cb < 4; ++cb) acc[ti][cb] = __builtin_amdgcn_mfma_f32_16x16x32_bf16(a, bf[cb], acc[ti][cb], 0, 0, 0);
            }
        }
    }
    __syncthreads();
    {
        const bf16_t* cc = (const bf16_t*)(ws + WS_CCAR) + ((size_t)(g * 512 + l15)) * 128 + 8 * gq;
#pragma unroll
        for (int ks = 0; ks < 4; ++ks) {
            bf16x8 bf[4];
#pragma unroll
            for (int cb = 0; cb < 4; ++cb) bf[cb] = *(const LAS bf16x8*)(L + HOFF + (16 * cb + l15) * HSTR + ks * 64 + gq * 16);
#pragma unroll
            for (int ti = 0; ti < 4; ++ti) {
                const int t = wid + 8 * ti;
                const bf16x8 a = *(const bf16x8*)(cc + (size_t)(16 * t) * 128 + 32 * ks);
#pragma unroll
                for (int cb = 0; cb < 4; ++cb) acc[ti][cb] = __builtin_amdgcn_mfma_f32_16x16x32_bf16(a, bf[cb], acc[ti][cb], 0, 0, 0);
            }
        }
    }
    bf16_t* YS = (bf16_t*)(ws + WS_YS);
#pragma unroll
    for (int ti = 0; ti < 4; ++ti)
#pragma unroll
        for (int cb = 0; cb < 4; ++cb) {
            const int t = wid + 8 * ti, nn = 16 * cb + l15;
            u32x2 w; w.x = cvt_pk_bf16(acc[ti][cb][0], acc[ti][cb][1]); w.y = cvt_pk_bf16(acc[ti][cb][2], acc[ti][cb][3]);
            *(u32x2*)(YS + (size_t)(b * SEQ + 32 * nn + t) * SW + g * 16 + 4 * gq) = w;
        }
    __syncthreads();
}

__device__ __forceinline__ void sample_spatial_row(const Args& args, int i, int lane) {
    unsigned char* ws = args.ws; const int r = MPR + i;
    const f32x2 pv = *(const f32x2*)((const float*)(ws + WS_VSTS) + ((size_t)i * 64 + lane) * 2);
    const float s1 = wave_sum(pv.x), s2 = wave_sum(pv.y);
    const float mean = s1 * (1.0f / D), rstd = 1.0f / sqrtf(s2 * (1.0f / D) - mean * mean + EPS);
    const bf16_t* GV = (const bf16_t*)(ws + WS_GV) + (size_t)r * D; const bf16_t* Ub = (const bf16_t*)(ws + WS_U) + (size_t)r * D; bf16_t* Gb = (bf16_t*)(ws + WS_XB) + (size_t)r * D;
#pragma unroll
    for (int j = 0; j < 4; ++j) {
        const int c = lane * 4 + 256 * j, g = c >> 7;
        const u32x2 gv = *(const u32x2*)(GV + c), uu = *(const u32x2*)(Ub + c);
        const f32x4 lg = *(const f32x4*)(args.in[I_LVG] + c), lb = *(const f32x4*)(args.in[I_LVB] + c);
        f32x4 vn;
        vn[0] = (bf_lo(gv.x) - mean) * rstd * lg[0] + lb[0]; vn[1] = (bf_hi(gv.x) - mean) * rstd * lg[1] + lb[1];
        vn[2] = (bf_lo(gv.y) - mean) * rstd * lg[2] + lb[2]; vn[3] = (bf_hi(gv.y) - mean) * rstd * lg[3] + lb[3];
        *(f32x4*)(args.out + O_CV + (size_t)i * D + c) = vn;
        const float w00 = args.in[I_WSP][(size_t)g * 16384], b0 = args.in[I_BSP][g * 128];
        u32x2 w;
        w.x = cvt_pk_bf16(bf_lo(uu.x) * (w00 * vn[0] + b0), bf_hi(uu.x) * (w00 * vn[1] + b0));
        w.y = cvt_pk_bf16(bf_lo(uu.y) * (w00 * vn[2] + b0), bf_hi(uu.y) * (w00 * vn[3] + b0));
        *(u32x2*)(Gb + c) = w;
    }
}
__device__ __forceinline__ void sample_ssm(const Args& args, int i, int g, int lane) {
    unsigned char* ws = args.ws; const int p = lane, r = MPR + i;
    const float lr = args.in[I_LRE][g * 64 + p], li = args.in[I_LIM][g * 64 + p], dt = expf(args.in[I_LDT][g]);
    float ar, ai; cpow_lam(lr, li, dt, 1, ar, ai);
    float cr, ci; zoh_coef(lr, li, dt, cr, ci);
    const bf16_t* up = (const bf16_t*)(ws + WS_SB) + ((size_t)g * MP + r) * 16;
    const u32x4 u0 = *(const u32x4*)up, u1 = *(const u32x4*)(up + 8);
    float uu[16];
    uu[0] = bf_lo(u0.x); uu[1] = bf_hi(u0.x); uu[2] = bf_lo(u0.y); uu[3] = bf_hi(u0.y); uu[4] = bf_lo(u0.z); uu[5] = bf_hi(u0.z); uu[6] = bf_lo(u0.w); uu[7] = bf_hi(u0.w);
    uu[8] = bf_lo(u1.x); uu[9] = bf_hi(u1.x); uu[10] = bf_lo(u1.y); uu[11] = bf_hi(u1.y); uu[12] = bf_lo(u1.z); uu[13] = bf_hi(u1.z); uu[14] = bf_lo(u1.w); uu[15] = bf_hi(u1.w);
    const float* bre = args.in[I_BRE] + (size_t)(g * 64 + p) * 16; const float* bim = args.in[I_BIM] + (size_t)(g * 64 + p) * 16;
    float br = 0.f, bi = 0.f;
#pragma unroll
    for (int j = 0; j < 16; ++j) { br += bre[j] * uu[j]; bi += bim[j] * uu[j]; }
    const float h0r = args.in[I_SRE][(size_t)(i * SG + g) * SP + p], h0i = args.in[I_SIM][(size_t)(i * SG + g) * SP + p];
    const float hr = ar * h0r - ai * h0i + (cr * br - ci * bi), hi = ar * h0i + ai * h0r + (cr * bi + ci * br);
    args.out[O_SRE + (size_t)(i * SG + g) * SP + p] = hr;
    args.out[O_SIM + (size_t)(i * SG + g) * SP + p] = hi;
    float mine = 0.f;
#pragma unroll
    for (int h = 0; h < 16; ++h) {
        float v = args.in[I_CRE][(size_t)(g * 16 + h) * 64 + p] * hr - args.in[I_CIM][(size_t)(g * 16 + h) * 64 + p] * hi;
        v = wave_sum(v);
        v += args.in[I_SD][g * 16 + h] * uu[h];
        if (lane == h) mine = v;
    }
    if (lane < 16) ((bf16_t*)(ws + WS_YS))[(size_t)r * SW + g * 16 + lane] = (bf16_t)(cvt_pk_bf16(mine, 0.f) & 0xffffu);
}

__global__ void __launch_bounds__(NTHR, 2) mega_fwd(Args args) {
    extern __shared__ __attribute__((aligned(16))) unsigned char lds[];
    LAS unsigned char* L = (LAS unsigned char*)lds;
    volatile LAS unsigned* MISC = (volatile LAS unsigned*)(L + LDSCTL_OFF + 320);
    const int tid = threadIdx.x, lane = tid & 63, wave = __builtin_amdgcn_readfirstlane(tid >> 6);
    const int G = gridDim.x; const int bx = blockIdx.x; const int vcu = (G % 8 == 0) ? (bx % 8) * (G / 8) + bx / 8 : bx;
    for (int u = tid; u < (LDS_BYTES - LDSCTL_OFF) / 4; u += NTHR) ((LAS unsigned*)(L + LDSCTL_OFF))[u] = 0u;
    __syncthreads();
    unsigned char* ws = args.ws;
    unsigned* ctl = (unsigned*)(ws + WS_CTL);
    const bool multi = (args.ph_hi - args.ph_lo) > 1;
    XcdBarrier bar; bar.bar = ctl + CW_BAR; bar.x = 0; bar.st = nullptr;
    if (multi) bar = xcd_barrier_post(ctl + CW_BAR, MISC + 8);
    const int lo = args.ph_lo, hi = args.ph_hi;
#define IN(k) (lo <= (k) && (k) < hi)
#define SEAM(k) do { if (IN(k) && IN((k) + 1)) xcd_barrier(bar); } while (0)

    if (IN(0)) { p0_prologue(args, L, vcu, G, tid, wave, lane); } SEAM(0);

    if (IN(1)) {
        pg8::Gemm g{(const bf16_t*)(ws + WS_XB), (const bf16_t*)(ws + WS_WIN), MPR, NIN, D}; pg8::StaticOrder S; S.init(MPR, NIN, G, bx);
        Epi1 E{(bf16_t*)(ws + WS_U), (bf16_t*)(ws + WS_GV), (bf16_t*)(ws + WS_SB), (bf16_t*)(ws + WS_SGA), (bf16_t*)(ws + WS_SGB), (const float*)(ws + WS_RSTD1), (float*)(ws + WS_VSTAT)};
        pg8::gemm_phase<Epi1, pg8::StaticOrder, true>(L, g, S, E);
        const int sj0 = (G == 256) ? bx - 128 : bx;
        for (int j = sj0; j >= 0 && j < NIN / 32; j += (G == 256 ? 128 : G)) {
            Side1 F{(bf16_t*)(ws + WS_U), (bf16_t*)(ws + WS_GV), (bf16_t*)(ws + WS_SB), (bf16_t*)(ws + WS_SGA), (bf16_t*)(ws + WS_SGB), (const float*)(ws + WS_RSTD1), (float*)(ws + WS_VSTS), 32 * j};
            const bf16_t* Bt = (const bf16_t*)(ws + WS_WIN) + (size_t)(32 * j) * D;
            side_unit<2, D, Side1>((const bf16_t*)(ws + WS_XB) + (size_t)MPR * D, Bt, Bt + (size_t)16 * D, F, wave, lane);
        }
    } SEAM(1);

    if (IN(2)) {
        for (int u = vcu; u < NB * SG; u += G) ssm_unit(args, L, u & 7, u >> 3, tid, wave, lane);
        for (int u = vcu; u < NB * 16 * 8; u += G) spatial_unit(args, L, (u >> 3) & 7, u >> 6, u & 7, tid, wave, lane);
        const int gw = vcu * NWAVES + wave, NGW = G * NWAVES;
        for (int i = gw; i < MSA; i += NGW) sample_spatial_row(args, i, lane);
        for (int q = gw; q < MSA * SG; q += NGW) sample_ssm(args, q >> 5, q & 31, lane);
    } SEAM(2);

    if (IN(3)) {
        pg8::Gemm g{(const bf16_t*)(ws + WS_YS), (const bf16_t*)(ws + WS_WB), MPR, 2 * D, SW}; pg8::StaticOrder S; S.init(MPR, 2 * D, G, bx);
        Epi3a E{(bf16_t*)(ws + WS_T2), (const bf16_t*)(ws + WS_SGB)};
        pg8::gemm_phase<Epi3a, pg8::StaticOrder, true>(L, g, S, E);
        for (int j = bx; j < D / 16; j += G) {
            const int c0 = 16 * j; Side3a F{(bf16_t*)(ws + WS_T2), (const bf16_t*)(ws + WS_SGB), c0};
            const bf16_t* Bt = (const bf16_t*)(ws + WS_WB) + (size_t)((c0 >> 7) * 256 + (c0 & 127)) * SW;
            side_unit<2, SW, Side3a>((const bf16_t*)(ws + WS_YS) + (size_t)MPR * SW, Bt, Bt + (size_t)128 * SW, F, wave, lane);
        }
    } SEAM(3);

    if (IN(4)) {
        pg8::Gemm g{(const bf16_t*)(ws + WS_XB), (const bf16_t*)(ws + WS_WA), MPR, D, D}; pg8::StaticOrder S; S.init(MPR, D, G, bx);
        Epi3b E{(bf16_t*)(ws + WS_U), (const bf16_t*)(ws + WS_SGA), (const bf16_t*)(ws + WS_T2)};
        pg8::gemm_phase<Epi3b, pg8::StaticOrder, true>(L, g, S, E);
        for (int j = bx; j < D / 16; j += G) {
            const int c0 = 16 * j; Side3b F{(bf16_t*)(ws + WS_U), (const bf16_t*)(ws + WS_SGA), (const bf16_t*)(ws + WS_T2), c0};
            const bf16_t* Bt = (const bf16_t*)(ws + WS_WA) + (size_t)c0 * D;
            side_unit<1, D, Side3b>((const bf16_t*)(ws + WS_XB) + (size_t)MPR * D, Bt, Bt, F, wave, lane);
        }
    } SEAM(4);

    if (IN(5)) {
        pg8::Gemm g{(const bf16_t*)(ws + WS_U), (const bf16_t*)(ws + WS_WO), MPR, D, D}; pg8::StaticOrder S; S.init(MPR, D, G, bx);
        Epi4 E{args.in[I_XP], args.in[I_XS], args.out, (bf16_t*)(ws + WS_GV), (float*)(ws + WS_RS2P)};
        pg8::gemm_phase<Epi4, pg8::StaticOrder, true>(L, g, S, E);
        for (int j = bx; j < D / 16; j += G) {
            const int c0 = 16 * j; Side4 F{args.in[I_XS], args.out, (bf16_t*)(ws + WS_GV), (float*)(ws + WS_RS2S), c0};
            const bf16_t* Bt = (const bf16_t*)(ws + WS_WO) + (size_t)c0 * D;
            side_unit<1, D, Side4>((const bf16_t*)(ws + WS_U) + (size_t)MPR * D, Bt, Bt, F, wave, lane);
        }
    } SEAM(5);

    if (IN(6)) {
        pg8::Gemm g{(const bf16_t*)(ws + WS_GV), (const bf16_t*)(ws + WS_WGU), MPR, NGU, D}; pg8::StaticOrder S; S.init(MPR, NGU, G, bx);
        Epi5 E{(bf16_t*)(ws + WS_SGA), (const float*)(ws + WS_RS2P)};
        pg8::gemm_phase<Epi5, pg8::StaticOrder, true>(L, g, S, E);
        const int sj0 = (G == 256) ? bx - 128 : bx;
        for (int j = sj0; j >= 0 && j < DFF / 16; j += (G == 256 ? 128 : G)) {
            const int c0 = 16 * j; Side5 F{(bf16_t*)(ws + WS_SGA), (const float*)(ws + WS_RS2S), c0};
            const bf16_t* Bt = (const bf16_t*)(ws + WS_WGU) + (size_t)((c0 >> 7) * 256 + (c0 & 127)) * D;
            side_unit<2, D, Side5>((const bf16_t*)(ws + WS_GV) + (size_t)MPR * D, Bt, Bt + (size_t)128 * D, F, wave, lane);
        }
    } SEAM(6);

    if (IN(7)) {
        pg8::Gemm g{(const bf16_t*)(ws + WS_SGA), (const bf16_t*)(ws + WS_WD), MPR, D, DFF}; pg8::StaticOrder S; S.init(MPR, D, G, bx);
        Epi6 E{args.out, (float*)(ws + WS_RS3P)};
        pg8::gemm_phase<Epi6, pg8::StaticOrder, true>(L, g, S, E);
        for (int j = bx; j < D / 16; j += G) {
            const int c0 = 16 * j; Side6 F{args.out, (float*)(ws + WS_RS3S), c0};
            const bf16_t* Bt = (const bf16_t*)(ws + WS_WD) + (size_t)c0 * DFF;
            side_unit<1, DFF, Side6>((const bf16_t*)(ws + WS_SGA) + (size_t)MPR * DFF, Bt, Bt, F, wave, lane);
        }
    } SEAM(7);

    if (IN(8)) {
        const int gw = vcu * NWAVES + wave, NGW = G * NWAVES;
        const float* rsp = (const float*)(ws + WS_RS3P); const f32x4* gf = (const f32x4*)args.in[I_GF] + lane;
        for (int m0 = 4 * gw; m0 < MREAL; m0 += 4 * NGW) {
            f32x4 v[4][4]; float rr[4];
#pragma unroll
            for (int q = 0; q < 4; ++q) { const int m = m0 + q; const f32x4* xr = (const f32x4*)(args.out + (size_t)m * D) + lane;
#pragma unroll
                for (int j = 0; j < 4; ++j) v[q][j] = xr[64 * j];
                float s;
                if (m < MPR) {
                    const f32x4* p = (const f32x4*)(rsp + (size_t)m * 16);
                    const f32x4 a = p[0], b = p[1], c = p[2], d = p[3];
                    s = ((a[0] + a[1]) + (a[2] + a[3])) + ((b[0] + b[1]) + (b[2] + b[3])) + ((c[0] + c[1]) + (c[2] + c[3])) + ((d[0] + d[1]) + (d[2] + d[3]));
                } else s = wave_sum(((const float*)(ws + WS_RS3S))[(size_t)(m - MPR) * 64 + lane]);
                rr[q] = 1.0f / sqrtf(s * (1.0f / D) + EPS); }
#pragma unroll
            for (int q = 0; q < 4; ++q) { f32x4* xr = (f32x4*)(args.out + (size_t)(m0 + q) * D) + lane;
#pragma unroll
                for (int j = 0; j < 4; ++j) xr[64 * j] = v[q][j] * rr[q] * gf[64 * j]; }
        }
    }
#ifdef DBG_DUMP
    if (IN(9)) {
        const bf16_t* src = (const bf16_t*)(ws + (DBG_DUMP == 1 ? WS_XB : DBG_DUMP == 2 ? WS_YS : DBG_DUMP == 3 ? WS_T2 : DBG_DUMP == 5 ? WS_GV : WS_U));
        const size_t n = (DBG_DUMP == 2) ? (size_t)MREAL * SW : (size_t)MREAL * D;
        for (size_t i = (size_t)bx * NTHR + tid; i < (size_t)MREAL * D; i += (size_t)G * NTHR) {
            float v = i < n ? bf1(src[i]) : 0.f;
            if (DBG_DUMP == 6) v = i < (size_t)MREAL * 32 ? ((const float*)(ws + WS_VSTAT))[i] : 0.f;
            if (!(v == v) || fabsf(v) > 1e30f) v = 1e30f;
            args.out[i] = v;
        }
    }
#endif
#undef IN
#undef SEAM
}

#ifndef MK_N_LAUNCHES
#define MK_N_LAUNCHES 1
#endif
extern "C" void kernel_launch(void* const* d_in, const int* in_sizes, int n_in, void* d_out, int out_size, void* d_ws, size_t ws_size, hipStream_t stream) {
    static int grid = 0;
    if (grid == 0) {
        int dev = 0, cus = 0, per_cu = 0;
        if (n_in != 26 || out_size != 17596416 || ws_size < WS_END) { fprintf(stderr, "kernel_launch: unexpected sizes n_in %d out %d ws %zu (need %zu)\n", n_in, out_size, ws_size, (size_t)WS_END); grid = -1; return; }
        if (hipGetDevice(&dev) != hipSuccess || hipDeviceGetAttribute(&cus, hipDeviceAttributeMultiprocessorCount, dev) != hipSuccess) { fprintf(stderr, "kernel_launch: device query failed\n"); grid = -1; return; }
        if (hipFuncSetAttribute((const void*)mega_fwd, hipFuncAttributeMaxDynamicSharedMemorySize, LDS_BYTES) != hipSuccess) { fprintf(stderr, "kernel_launch: hipFuncSetAttribute failed\n"); grid = -1; return; }
        if (hipOccupancyMaxActiveBlocksPerMultiprocessor(&per_cu, (const void*)mega_fwd, NTHR, LDS_BYTES) != hipSuccess || per_cu < 1) { fprintf(stderr, "kernel_launch: occupancy query says %d blocks per CU\n", per_cu); (void)hipGetLastError(); grid = -1; return; }
        (void)hipGetLastError();
        grid = cus;
    }
    if (grid < 0) return;
    (void)hipMemsetAsync((char*)d_ws + WS_CTL, 0, CTL_ZERO_BYTES, stream);
    Args a{};
    for (int i = 0; i < 26; ++i) a.in[i] = (const float*)d_in[i];
    a.out = (float*)d_out; a.ws = (unsigned char*)d_ws;
    if (MK_N_LAUNCHES == 1) { a.ph_lo = 0; a.ph_hi = 9; hipLaunchKernelGGL(mega_fwd, dim3(grid), dim3(NTHR), LDS_BYTES, stream, a); }
    else { for (int p = 0; p < DBG_NPH; ++p) { a.ph_lo = (p == DBG_NPH - 1 && DBG_LASTPH >= 0) ? DBG_LASTPH : p; a.ph_hi = a.ph_lo + 1; hipLaunchKernelGGL(mega_fwd, dim3(grid), dim3(NTHR), LDS_BYTES, stream, a); } }
}
```
